# Optimizing an MI355X kernel written in HIP

```python
import math
import jax, jax.numpy as jnp
from jax import lax
import numpy as np

D_MODEL = 1024
BATCH = 4
SEQ = 4096
DEPTH = 2

CHUNK = 64
HEAD_DIM = 64
RET_HEADS = 6
SB_HEADS = 6
GLA_HEADS = 4
RET_W = RET_HEADS * HEAD_DIM
SB_W = SB_HEADS * HEAD_DIM
GLA_W = GLA_HEADS * HEAD_DIM
GLA_GATE_RANK = 16
GLA_TAU = 16.0
D_FF = 2816
FFN_CONV = 3
SB_BLOCK = 128
ROPE_BASE = 10000.0
EPS = 1e-6
IN_COLS = 4 * RET_W + 3 * SB_W + 4 * GLA_W + GLA_GATE_RANK

kernel_name = "hybrid_retention_stickbreak_gla_convffn"


def rmsnorm(x, g):
    xf = x.astype(jnp.float32)
    y = xf * lax.rsqrt(jnp.mean(xf * xf, axis=-1, keepdims=True) + EPS)
    return (y * g.astype(jnp.float32)).astype(x.dtype)


def split_heads(t, n_heads):
    b, s, _ = t.shape
    return t.reshape(b, s, n_heads, HEAD_DIM).transpose(0, 2, 1, 3)


def merge_heads(t):
    b, h, s, d = t.shape
    return t.transpose(0, 2, 1, 3).reshape(b, s, h * d)


def rotary(t):
    s, d = t.shape[2], t.shape[3]
    half = d // 2
    pos = jnp.arange(s, dtype=jnp.float32)
    freqs = ROPE_BASE ** (-jnp.arange(half, dtype=jnp.float32) / half)
    ang = pos[:, None] * freqs[None, :]
    cos, sin = jnp.cos(ang), jnp.sin(ang)
    tf = t.astype(jnp.float32)
    t1, t2 = tf[..., :half], tf[..., half:]
    return jnp.concatenate([t1 * cos - t2 * sin, t1 * sin + t2 * cos], axis=-1)


def head_groupnorm(o, g):
    h, d = o.shape[1], o.shape[3]
    mu = jnp.mean(o, axis=-1, keepdims=True)
    var = jnp.mean(jnp.square(o - mu), axis=-1, keepdims=True)
    return (o - mu) * lax.rsqrt(var + EPS) * g.astype(jnp.float32).reshape(h, 1, d)


def head_rmsnorm(o, g):
    h, d = o.shape[1], o.shape[3]
    return o * lax.rsqrt(jnp.mean(o * o, axis=-1, keepdims=True) + EPS) * g.astype(jnp.float32).reshape(h, 1, d)


def retention(q, k, v):
    b, h, s, d = q.shape
    n = s // CHUNK
    log_gamma = jnp.log1p(-(2.0 ** (-5.0 - jnp.arange(h, dtype=jnp.float32))))
    qc = q.reshape(b, h, n, CHUNK, d)
    kc = k.reshape(b, h, n, CHUNK, d) * (d ** -0.5)
    vc = v.reshape(b, h, n, CHUNK, d)
    pos = jnp.arange(CHUNK, dtype=jnp.float32)
    rel = jnp.abs(pos[:, None] - pos[None, :])
    d_intra = jnp.exp(log_gamma[:, None, None] * rel)
    scores = jnp.einsum('bhncd,bhnsd->bhncs', qc, kc) * d_intra[None, :, None]
    intra = jnp.einsum('bhncs,bhnse->bhnce', scores, vc)
    k_decay = jnp.exp(log_gamma[:, None] * (CHUNK - 1 - pos))
    kv = jnp.einsum('bhnsd,bhnse->bhnde', kc * k_decay[None, :, None, :, None], vc)
    chunk_decay = jnp.exp(log_gamma * CHUNK)[None, :, None, None]

    def step(state, kv_i):
        return chunk_decay * state + kv_i, state

    _, prev = lax.scan(step, jnp.zeros((b, h, d, d), jnp.float32), jnp.moveaxis(kv, 2, 0))
    prev = jnp.moveaxis(prev, 0, 2)
    q_decay = jnp.exp(log_gamma[:, None] * (pos + 1.0))
    inter = jnp.einsum('bhncd,bhnde->bhnce', qc * q_decay[None, :, None, :, None], prev)
    return (intra + inter).reshape(b, h, s, d)


def stick_breaking(q, k, v):
    b, h, s, d = q.shape
    scale = d ** -0.5
    outs = []
    for blk in range(s // SB_BLOCK):
        q0 = blk * SB_BLOCK
        end = q0 + SB_BLOCK
        z = jnp.einsum('bhtd,bhsd->bhts', q[:, :, q0:end], k[:, :, :end]) * scale
        t_idx = q0 + jnp.arange(SB_BLOCK)
        s_idx = jnp.arange(end)
        strict = s_idx[None, :] < t_idx[:, None]
        log_keep = jnp.where(strict, jax.nn.log_sigmoid(-z), 0.0)
        between = lax.cumsum(log_keep, axis=3, reverse=True) - log_keep
        a = jnp.where(strict, jnp.exp(jax.nn.log_sigmoid(z) + between), 0.0)
        outs.append(jnp.einsum('bhts,bhse->bhte', a, v[:, :, :end]))
    return jnp.concatenate(outs, axis=2)


def gla(q, k, v, log_alpha):
    b, h, s, d = q.shape
    n = s // CHUNK
    qc = q.reshape(b, h, n, CHUNK, d) * (d ** -0.5)
    kc = k.reshape(b, h, n, CHUNK, d)
    vc = v.reshape(b, h, n, CHUNK, d)
    bcum = jnp.cumsum(log_alpha.reshape(b, h, n, CHUNK, d), axis=3)
    blast = bcum[:, :, :, -1]
    kv = jnp.einsum('bhnsd,bhnse->bhnde', kc * jnp.exp(blast[:, :, :, None] - bcum), vc)

    def step(state, inp):
        q_i, k_i, v_i, b_i, kv_i, bl_i = inp
        inter = jnp.einsum('bhcd,bhde->bhce', q_i * jnp.exp(b_i), state)
        w = jnp.exp(-jnp.abs(b_i[:, :, :, None, :] - b_i[:, :, None, :, :]))
        scores = jnp.einsum('bhtd,bhsd,bhtsd->bhts', q_i, k_i, w)
        intra = jnp.einsum('bhts,bhse->bhte', scores, v_i)
        new_state = jnp.exp(bl_i)[..., None] * state + kv_i
        return new_state, inter + intra

    xs = tuple(jnp.moveaxis(t, 2, 0) for t in (qc, kc, vc, bcum, kv, blast))
    _, out = lax.scan(step, jnp.zeros((b, h, d, d), jnp.float32), xs)
    return jnp.moveaxis(out, 0, 2).reshape(b, h, s, d)


def token_mixer(hn, w_in, gla_w2, gla_b, ret_norm_g, gla_norm_g, w_out):
    widths = [RET_W] * 4 + [SB_W] * 3 + [GLA_W] * 4 + [GLA_GATE_RANK]
    idx = []
    acc = 0
    for wd in widths[:-1]:
        acc += wd
        idx.append(acc)
    proj = (hn @ w_in).astype(jnp.float32)
    rq, rk, rv, rg, sq, sk, sv, gq, gk, gv, gg, glr = jnp.split(proj, idx, axis=-1)
    ret = retention(rotary(split_heads(rq, RET_HEADS)), rotary(split_heads(rk, RET_HEADS)),
                    split_heads(rv, RET_HEADS))
    ret = merge_heads(head_groupnorm(ret, ret_norm_g)) * jax.nn.silu(rg)
    sb = merge_heads(stick_breaking(split_heads(sq, SB_HEADS), split_heads(sk, SB_HEADS),
                                    split_heads(sv, SB_HEADS)))
    log_alpha = jax.nn.log_sigmoid(glr @ gla_w2.astype(jnp.float32) + gla_b.astype(jnp.float32)) / GLA_TAU
    go = gla(split_heads(gq, GLA_HEADS), split_heads(gk, GLA_HEADS), split_heads(gv, GLA_HEADS),
             split_heads(log_alpha, GLA_HEADS))
    go = merge_heads(head_rmsnorm(go, gla_norm_g)) * jax.nn.silu(gg)
    mixed = jnp.concatenate([ret, sb, go], axis=-1).astype(hn.dtype)
    return mixed @ w_out


def conv_ffn(hn, w_up, conv_w, conv_b, w_down):
    s = hn.shape[1]
    up = hn @ w_up
    a, val = jnp.split(up, 2, axis=-1)
    ap = jnp.pad(a, ((0, 0), (FFN_CONV - 1, 0), (0, 0)))
    a = sum(ap[:, i:i + s] * conv_w[i] for i in range(FFN_CONV)) + conv_b
    return (jax.nn.gelu(a) * val) @ w_down


def setup_inputs(seed: int = 0) -> dict:
    key = jax.random.key(seed)
    ks = jax.random.split(key, 20)
    f32 = jnp.float32
    nrm = lambda k, shape, sc: jax.random.normal(k, shape, f32) * sc
    L, D = DEPTH, D_MODEL
    return {
        "x": nrm(ks[0], (BATCH, SEQ, D), 1.0),
        "c": nrm(ks[1], (BATCH, D), 1.0),
        "ada_w": nrm(ks[2], (L, D, 6 * D), 0.5 * D ** -0.5),
        "ada_b": nrm(ks[3], (L, 6 * D), 0.02),
        "pre_mix_g": 1.0 + nrm(ks[4], (L, D), 0.05),
        "post_mix_g": 1.0 + nrm(ks[5], (L, D), 0.05),
        "w_in": nrm(ks[6], (L, D, IN_COLS), D ** -0.5),
        "gla_w2": nrm(ks[7], (L, GLA_GATE_RANK, GLA_W), GLA_GATE_RANK ** -0.5),
        "gla_b": nrm(ks[8], (L, GLA_W), 0.1),
        "ret_norm_g": 1.0 + nrm(ks[9], (L, RET_W), 0.05),
        "gla_norm_g": 1.0 + nrm(ks[10], (L, GLA_W), 0.05),
        "w_out": nrm(ks[11], (L, D, D), D ** -0.5),
        "pre_ffn_g": 1.0 + nrm(ks[12], (L, D), 0.05),
        "post_ffn_g": 1.0 + nrm(ks[13], (L, D), 0.05),
        "w_up": nrm(ks[14], (L, D, 2 * D_FF), D ** -0.5),
        "conv_w": nrm(ks[15], (L, FFN_CONV, D_FF), FFN_CONV ** -0.5),
        "conv_b": nrm(ks[16], (L, D_FF), 0.02),
        "w_down": nrm(ks[17], (L, D_FF, D), D_FF ** -0.5),
    }


def reference(x, c, ada_w, ada_b, pre_mix_g, post_mix_g, w_in, gla_w2, gla_b, ret_norm_g,
              gla_norm_g, w_out, pre_ffn_g, post_ffn_g, w_up, conv_w, conv_b, w_down):
    for l in range(DEPTH):
        mod = jax.nn.silu(c) @ ada_w[l] + ada_b[l]
        sh1, sc1, g1, sh2, sc2, g2 = jnp.split(mod[:, None, :], 6, axis=-1)
        hn = rmsnorm(x, pre_mix_g[l]) * (1.0 + sc1) + sh1
        y = token_mixer(hn, w_in[l], gla_w2[l], gla_b[l], ret_norm_g[l], gla_norm_g[l], w_out[l])
        x = x + g1 * rmsnorm(y, post_mix_g[l])
        hn = rmsnorm(x, pre_ffn_g[l]) * (1.0 + sc2) + sh2
        y = conv_ffn(hn, w_up[l], conv_w[l], conv_b[l], w_down[l])
        x = x + g2 * rmsnorm(y, post_ffn_g[l])
    return x
```

```cpp
#include <hip/hip_runtime.h>
#include <hip/hip_cooperative_groups.h>
#include <cstdio>
#include <cstdint>
namespace cg = cooperative_groups;

#ifndef DUPMASK
#define DUPMASK 0
#endif
#ifndef MODE_MULTI
#define MODE_MULTI 0
#endif

typedef unsigned short bf16_t;
typedef short bf16x8 __attribute__((ext_vector_type(8)));
typedef float f32x4 __attribute__((ext_vector_type(4)));
typedef unsigned u32x4 __attribute__((ext_vector_type(4)));
typedef unsigned u32x2 __attribute__((ext_vector_type(2)));

#define NTOK 16384
#define SEQ 4096
#define DM 1024
#define IN_COLS 3728
#define IN_PAD 3840
#define DFF 2816
#define LSTR 72
#define LDS_BYTES 65536
#define EPSF 1e-6f
#define LOG2E 1.4426950408889634f
#define MOD_PLANE (2 * 4 * 6144)

struct Params {
  const float *x, *c, *ada_w, *ada_b, *pre_mix_g, *post_mix_g, *w_in, *gla_w2, *gla_b, *ret_norm_g, *gla_norm_g,
      *w_out, *pre_ffn_g, *post_ffn_g, *w_up, *conv_w, *conv_b, *w_down;
  float* out;
  bf16_t *wt_in, *wt_out, *wt_up, *wt_down;
  float* mod;
  bf16_t* hn;
  bf16_t *lq, *lk, *lvt, *lg, *sq, *sk, *svt;
  float* glr;
  bf16_t* hbuf;
  bf16_t* y;
  float* kvt;
  bf16_t* st;
  float* bl;
  unsigned* bar;
};
typedef const __attribute__((address_space(4))) Params KParams;

__constant__ float ROPE_HI[32] = {1.591549367e-01f, 1.193493679e-01f, 8.949939907e-02f, 6.711508334e-02f, 5.032921210e-02f, 3.774158657e-02f, 2.830219641e-02f, 2.122365311e-02f, 1.591549441e-02f, 1.193493698e-02f, 8.949940093e-03f, 6.711508147e-03f, 5.032921210e-03f, 3.774158424e-03f, 2.830219688e-03f, 2.122365171e-03f, 1.591549488e-03f, 1.193493721e-03f, 8.949940093e-04f, 6.711508031e-04f, 5.032921326e-04f, 3.774158540e-04f, 2.830219455e-04f, 2.122365258e-04f, 1.591549371e-04f, 1.193493736e-04f, 8.949940093e-05f, 6.711508468e-05f, 5.032921035e-05f, 3.774158540e-05f, 2.830219637e-05f, 2.122365186e-05f};
__constant__ float ROPE_LO[32] = {6.420638243e-09f, 2.294664903e-09f, 2.542919653e-09f, -3.316028840e-10f, 5.173299289e-12f, -1.848551645e-09f, -5.826552019e-10f, -3.431038786e-10f, -1.029942243e-10f, 4.320196978e-11f, 6.802745173e-11f, 1.531042237e-10f, 5.173301024e-13f, 4.797548470e-11f, -1.048316434e-10f, 1.053879969e-10f, -5.686555046e-11f, -1.896286773e-11f, 6.802744999e-12f, 2.695195456e-11f, -1.158979943e-11f, -6.843983713e-12f, 1.279990003e-11f, 1.807650600e-12f, 5.954976963e-12f, -3.351478166e-12f, 6.802745216e-13f, -1.670379113e-12f, 1.751403167e-12f, -6.843983930e-13f, -5.389994549e-13f, 9.083608431e-13f};
__constant__ float LOG_GAMMA[6] = {-3.174869716e-02f, -1.574835740e-02f, -7.843177766e-03f, -3.913899418e-03f, -1.955034910e-03f, -9.770396864e-04f};

typedef __bf16 bf16v2 __attribute__((ext_vector_type(2)));
__device__ __forceinline__ unsigned pack2(float a, float b) {
  bf16v2 v;
  v[0] = (__bf16)a;
  v[1] = (__bf16)b;
  return __builtin_bit_cast(unsigned, v);
}
__device__ __forceinline__ bf16_t f2bf(float f) { return (bf16_t)(pack2(f, 0.f) & 0xffffu); }
__device__ __forceinline__ float bf2f(bf16_t h) { return __uint_as_float(((unsigned)h) << 16); }
__device__ __forceinline__ f32x4 mfma16(bf16x8 a, bf16x8 b, f32x4 c) { return __builtin_amdgcn_mfma_f32_16x16x32_bf16(a, b, c, 0, 0, 0); }
__device__ __forceinline__ float fexp2(float x) { return __builtin_amdgcn_exp2f(x); }
__device__ __forceinline__ float flog2(float x) { return __builtin_amdgcn_logf(x); }
__device__ __forceinline__ float siluf(float x) { return x * __builtin_amdgcn_rcpf(1.f + __expf(-x)); }

__device__ __forceinline__ int OTID() { int t = __builtin_amdgcn_workitem_id_x(); asm volatile("" : "+v"(t)); return t; }
__device__ __forceinline__ int UWID(int tid) { return __builtin_amdgcn_readfirstlane(tid >> 6); }

union U4B8 { u32x4 u; bf16x8 v; };
union U2x2B8 { u32x2 u[2]; bf16x8 v; };

struct GTile { const bf16_t* A; const bf16_t* Bt; int lda, ldb, row0, rlo, rhi, col0; };
__device__ __forceinline__ void gemm_issue_tile(const GTile& g, int kt, unsigned char* buf, int wid, int lane) {
  const int lr = lane >> 3, lp = lane & 7;
#pragma unroll
  for (int i = 0; i < 4; ++i) {
    const int q = wid * 4 + i;
    const int r = q * 8 + lr;
    const int c = lp ^ ((r >> 1) & 7);
    int ra = g.row0 + r;
    ra = ra < g.rlo ? g.rlo : (ra > g.rhi ? g.rhi : ra);
    const int lo = __builtin_amdgcn_readfirstlane(q * 1024);
    __builtin_amdgcn_global_load_lds((const unsigned*)(g.A + (size_t)ra * g.lda + c * 8 + kt * 64), (unsigned*)(buf + lo), 16, 0, 0);
    __builtin_amdgcn_global_load_lds((const unsigned*)(g.Bt + (size_t)(g.col0 + r) * g.ldb + c * 8 + kt * 64), (unsigned*)(buf + 16384 + lo), 16, 0, 0);
  }
}
template <bool SWAP>
__device__ __forceinline__ void gemm_mainloop(const GTile& g, const GTile& gn, bool has_next, bool first, int K, unsigned char* base, f32x4 (&acc)[4][4]) {
  const int tid = OTID(), lane = tid & 63, wid = UWID(tid), wr = wid >> 1, wc = wid & 1, fr = lane & 15, fq = lane >> 4;
  const int lr = lane >> 3, lp = lane & 7;
  const bf16_t* ap[4];
  const bf16_t* bp[4];
  int loff[4];
#pragma unroll
  for (int i = 0; i < 4; ++i) {
    const int q = wid * 4 + i;
    const int r = q * 8 + lr;
    const int c = lp ^ ((r >> 1) & 7);
    int ra = g.row0 + r;
    ra = ra < g.rlo ? g.rlo : (ra > g.rhi ? g.rhi : ra);
    ap[i] = g.A + (size_t)ra * g.lda + c * 8;
    bp[i] = g.Bt + (size_t)(g.col0 + r) * g.ldb + c * 8;
    loff[i] = __builtin_amdgcn_readfirstlane(q * 1024);
  }
#pragma unroll
  for (int m = 0; m < 4; ++m)
#pragma unroll
    for (int n = 0; n < 4; ++n) acc[m][n] = (f32x4){0.f, 0.f, 0.f, 0.f};
  int aoff[4], boff[4];
#pragma unroll
  for (int m = 0; m < 4; ++m) { const int R = wr * 64 + m * 16 + fr; aoff[m] = R * 128; }
#pragma unroll
  for (int n = 0; n < 4; ++n) { const int R = wc * 64 + n * 16 + fr; boff[n] = 16384 + R * 128; }
  const int swz = (fr >> 1) & 7;
  const int nk = K >> 6;
#define GEMM_ISSUE(KT, BUFOFF) \
  _Pragma("unroll") for (int i = 0; i < 4; ++i) { \
    __builtin_amdgcn_global_load_lds((const unsigned*)(ap[i] + (KT) * 64), (unsigned*)(base + (BUFOFF) + loff[i]), 16, 0, 0); \
    __builtin_amdgcn_global_load_lds((const unsigned*)(bp[i] + (KT) * 64), (unsigned*)(base + (BUFOFF) + 16384 + loff[i]), 16, 0, 0); }
#define DSR(dst, addr, off) asm volatile("ds_read_b128 %0, %1 offset:%2" : "=v"(dst) : "v"(addr), "n"(off))
#define GEMM_COMPUTE(BUFOFF) \
  { bf16x8 af0[4], bf0[4], af1[4], bf1[4]; \
    DSR(af0[0], adrA0, (BUFOFF)); DSR(af0[1], adrA0, (BUFOFF) + 2048); DSR(af0[2], adrA0, (BUFOFF) + 4096); DSR(af0[3], adrA0, (BUFOFF) + 6144); \
    DSR(bf0[0], adrB0, (BUFOFF) + 16384); DSR(bf0[1], adrB0, (BUFOFF) + 18432); DSR(bf0[2], adrB0, (BUFOFF) + 20480); DSR(bf0[3], adrB0, (BUFOFF) + 22528); \
    DSR(af1[0], adrA1, (BUFOFF)); DSR(af1[1], adrA1, (BUFOFF) + 2048); DSR(af1[2], adrA1, (BUFOFF) + 4096); DSR(af1[3], adrA1, (BUFOFF) + 6144); \
    DSR(bf1[0], adrB1, (BUFOFF) + 16384); DSR(bf1[1], adrB1, (BUFOFF) + 18432); DSR(bf1[2], adrB1, (BUFOFF) + 20480); DSR(bf1[3], adrB1, (BUFOFF) + 22528); \
    asm volatile("s_waitcnt lgkmcnt(8)" : "+v"(af0[0]), "+v"(af0[1]), "+v"(af0[2]), "+v"(af0[3]), "+v"(bf0[0]), "+v"(bf0[1]), "+v"(bf0[2]), "+v"(bf0[3])); \
    __builtin_amdgcn_s_setprio(1); \
    _Pragma("unroll") for (int m = 0; m < 4; ++m) \
      _Pragma("unroll") for (int n = 0; n < 4; ++n) acc[m][n] = SWAP ? mfma16(af0[m], bf0[n], acc[m][n]) : mfma16(bf0[n], af0[m], acc[m][n]); \
    __builtin_amdgcn_sched_barrier(0); \
    asm volatile("s_waitcnt lgkmcnt(0)" : "+v"(af1[0]), "+v"(af1[1]), "+v"(af1[2]), "+v"(af1[3]), "+v"(bf1[0]), "+v"(bf1[1]), "+v"(bf1[2]), "+v"(bf1[3])); \
    __builtin_amdgcn_sched_barrier(0); \
    _Pragma("unroll") for (int m = 0; m < 4; ++m) \
      _Pragma("unroll") for (int n = 0; n < 4; ++n) acc[m][n] = SWAP ? mfma16(af1[m], bf1[n], acc[m][n]) : mfma16(bf1[n], af1[m], acc[m][n]); \
    __builtin_amdgcn_s_setprio(0); }
  const unsigned lbase = (unsigned)(size_t)base;
  const unsigned adrA0 = lbase + (wr * 64 + fr) * 128 + ((0 + fq) ^ swz) * 16, adrA1 = lbase + (wr * 64 + fr) * 128 + ((4 + fq) ^ swz) * 16;
  const unsigned adrB0 = lbase + (wc * 64 + fr) * 128 + ((0 + fq) ^ swz) * 16, adrB1 = lbase + (wc * 64 + fr) * 128 + ((4 + fq) ^ swz) * 16;
  if (first) {
    __syncthreads();
    GEMM_ISSUE(0, 0)
  }
  for (int kt = 0; kt < nk; kt += 2) {
    __syncthreads();
    GEMM_ISSUE(kt + 1, 32768)
    GEMM_COMPUTE(0)
    __syncthreads();
    if (kt + 2 < nk) { GEMM_ISSUE(kt + 2, 0) }
    else if (has_next) gemm_issue_tile(gn, 0, base, wid, lane);
    GEMM_COMPUTE(32768)
  }
}

__device__ __forceinline__ bool tile_map(int t, int MT, int NT, int& mt, int& nt) {
  const int MTm = MT & ~63;
  const int nmain = MTm * NT;
  if (t < nmain) {
    const int x = t & 7, u = t >> 3;
    const int g = u / (8 * NT), rem = u - g * (8 * NT);
    nt = rem >> 3;
    mt = ((g << 3) + (rem & 7)) * 8 + x;
  } else {
    const int r = t - nmain;
    mt = MTm + r / NT;
    nt = r % NT;
  }
  return true;
}
__device__ __forceinline__ int tile_count(int MT, int NT) { return MT * NT; }

__device__ __forceinline__ void store_rows_bf16(bf16_t* buf, int ld, int row0, int colbase, const f32x4 (&acc)[4][4], float scale, bool do_silu) {
  const int lane = OTID() & 63, wid = UWID(OTID()), wr = wid >> 1, fr = lane & 15, fq = lane >> 4;
#pragma unroll
  for (int m = 0; m < 4; ++m) {
    const int row = row0 + wr * 64 + m * 16 + fr;
#pragma unroll
    for (int n = 0; n < 4; ++n) {
      f32x4 v = acc[m][n];
      if (do_silu) { v[0] = siluf(v[0]); v[1] = siluf(v[1]); v[2] = siluf(v[2]); v[3] = siluf(v[3]); }
      u32x2 w;
      w.x = pack2(v[0] * scale, v[1] * scale);
      w.y = pack2(v[2] * scale, v[3] * scale);
      *(u32x2*)(buf + (size_t)row * ld + colbase + n * 16 + fq * 4) = w;
    }
  }
}

__device__ __forceinline__ void rotary_inplace(f32x4 (&acc)[4][4], int row0) {
  const int lane = OTID() & 63, wid = UWID(OTID()), wr = wid >> 1, fr = lane & 15, fq = lane >> 4;
#pragma unroll
  for (int m = 0; m < 4; ++m) {
    const float pos = (float)((row0 + wr * 64 + m * 16 + fr) & (SEQ - 1));
#pragma unroll
    for (int n = 0; n < 2; ++n) {
#pragma unroll
      for (int j = 0; j < 4; ++j) {
        const int i = n * 16 + fq * 4 + j;
        const float fh = ROPE_HI[i], fl = ROPE_LO[i];
        const float ph = pos * fh;
        const float pe = __builtin_fmaf(pos, fh, -ph);
        float rev = (ph - floorf(ph)) + (pe + pos * fl);
        const float sn = __builtin_amdgcn_sinf(rev), cs = __builtin_amdgcn_cosf(rev);
        const float t1 = acc[m][n][j], t2 = acc[m][n + 2][j];
        acc[m][n][j] = t1 * cs - t2 * sn;
        acc[m][n + 2][j] = t1 * sn + t2 * cs;
      }
    }
  }
}

__device__ __forceinline__ void proj_phase(KParams& p, int l, unsigned char* lds, int nb, int bid) {
  const bf16_t* Bt = p.wt_in;
  const int lane = OTID() & 63, wid = UWID(OTID()), wr = wid >> 1, wc = wid & 1, fr = lane & 15, fq = lane >> 4;
  const int NT = IN_PAD / 128;
  const int ntiles = tile_count(NTOK / 128, NT);
  for (int t = bid; t < ntiles; t += nb) {
    int mt, nt, mtn = 0, ntn = 0;
    tile_map(t, NTOK / 128, NT, mt, nt);
    const bool has_next = t + nb < ntiles;
    if (has_next) tile_map(t + nb, NTOK / 128, NT, mtn, ntn);
    const int row0 = mt * 128;
    GTile g, gn;
    g.A = p.hn; g.Bt = Bt; g.lda = DM; g.ldb = DM; g.row0 = row0; g.rlo = 0; g.rhi = NTOK - 1; g.col0 = nt * 128;
    gn = g; gn.row0 = mtn * 128; gn.col0 = ntn * 128;
    const bool vt = (nt >= 6 && nt < 9) || (nt >= 18 && nt < 21) || (nt >= 25 && nt < 27);
    f32x4 acc[4][4];
    if (vt) {
      gemm_mainloop<true>(g, gn, has_next, t == bid, DM, lds, acc);
      bf16_t* dst;
      int head, nh;
      if (nt < 9) { dst = p.lvt; head = (nt - 6) * 2 + wc; nh = 10; }
      else if (nt < 21) { dst = p.svt; head = (nt - 18) * 2 + wc; nh = 6; }
      else { dst = p.lvt; head = 6 + (nt - 25) * 2 + wc; nh = 10; }
      const int b = row0 >> 12;
#pragma unroll
      for (int m = 0; m < 4; ++m) {
        const int pos = ((row0 + wr * 64 + m * 16 + fq * 4) & (SEQ - 1));
#pragma unroll
        for (int n = 0; n < 4; ++n) {
          const int e = n * 16 + fr;
          u32x2 w;
          w.x = pack2(acc[m][n][0], acc[m][n][1]);
          w.y = pack2(acc[m][n][2], acc[m][n][3]);
          *(u32x2*)(dst + ((size_t)(b * nh + head) * 64 + e) * SEQ + pos) = w;
        }
      }
    } else {
      gemm_mainloop<false>(g, gn, has_next, t == bid, DM, lds, acc);
      if (nt < 3) { rotary_inplace(acc, row0); store_rows_bf16(p.lq, 640, row0, nt * 128 + wc * 64, acc, 0.125f, false); }
      else if (nt < 6) { rotary_inplace(acc, row0); store_rows_bf16(p.lk, 640, row0, (nt - 3) * 128 + wc * 64, acc, 1.f, false); }
      else if (nt < 12) { store_rows_bf16(p.lg, 640, row0, (nt - 9) * 128 + wc * 64, acc, 1.f, true); }
      else if (nt < 15) { store_rows_bf16(p.sq, 384, row0, (nt - 12) * 128 + wc * 64, acc, 0.125f * LOG2E, false); }
      else if (nt < 18) { store_rows_bf16(p.sk, 384, row0, (nt - 15) * 128 + wc * 64, acc, 1.f, false); }
      else if (nt < 23) { store_rows_bf16(p.lq, 640, row0, 384 + (nt - 21) * 128 + wc * 64, acc, 0.125f, false); }
      else if (nt < 25) { store_rows_bf16(p.lk, 640, row0, 384 + (nt - 23) * 128 + wc * 64, acc, 1.f, false); }
      else if (nt < 29) { store_rows_bf16(p.lg, 640, row0, 384 + (nt - 27) * 128 + wc * 64, acc, 1.f, true); }
      else {
        if (wc == 0) {
#pragma unroll
          for (int m = 0; m < 4; ++m) {
            const int row = row0 + wr * 64 + m * 16 + fr;
            *(f32x4*)(p.glr + (size_t)row * 16 + fq * 4) = acc[m][0];
          }
        }
      }
    }
  }
}

__device__ __forceinline__ void gemm_y_phase(KParams& p, const bf16_t* A, int K, const bf16_t* Bt, unsigned char* lds, int nb, int bid) {
  const int lane = OTID() & 63, wid = UWID(OTID()), wr = wid >> 1, wc = wid & 1, fr = lane & 15, fq = lane >> 4;
  const int NT = DM / 128;
  const int ntiles = tile_count(NTOK / 128, NT);
  for (int t = bid; t < ntiles; t += nb) {
    int mt, nt, mtn = 0, ntn = 0;
    tile_map(t, NTOK / 128, NT, mt, nt);
    const bool has_next = t + nb < ntiles;
    if (has_next) tile_map(t + nb, NTOK / 128, NT, mtn, ntn);
    const int row0 = mt * 128;
    GTile g, gn;
    g.A = A; g.Bt = Bt; g.lda = K; g.ldb = K; g.row0 = row0; g.rlo = 0; g.rhi = NTOK - 1; g.col0 = nt * 128;
    gn = g; gn.row0 = mtn * 128; gn.col0 = ntn * 128;
    f32x4 acc[4][4];
    gemm_mainloop<false>(g, gn, has_next, t == bid, K, lds, acc);
#pragma unroll
    for (int m = 0; m < 4; ++m) {
      const int row = row0 + wr * 64 + m * 16 + fr;
#pragma unroll
      for (int n = 0; n < 4; ++n) {
        u32x2 w;
        w.x = pack2(acc[m][n][0], acc[m][n][1]);
        w.y = pack2(acc[m][n][2], acc[m][n][3]);
        *(u32x2*)(p.y + (size_t)row * DM + nt * 128 + wc * 64 + n * 16 + fq * 4) = w;
      }
    }
  }
}

__device__ __forceinline__ void up_phase(KParams& p, int l, unsigned char* lds, int nb, int bid) {
  unsigned char* sAct = lds + 32768;
  const int lane = OTID() & 63, wid = UWID(OTID()), wr = wid >> 1, wc = wid & 1, fr = lane & 15, fq = lane >> 4;
  const int NT = DFF / 64;
  const int MT = 4 * 33;
  const int ntiles = tile_count(MT, NT);
  const float* cw = p.conv_w + (size_t)l * 3 * DFF;
  const float* cb = p.conv_b + (size_t)l * DFF;
  for (int t = bid; t < ntiles; t += nb) {
    int mt, nt, mtn = 0, ntn = 0;
    tile_map(t, MT, NT, mt, nt);
    const bool has_next = t + nb < ntiles;
    if (has_next) tile_map(t + nb, MT, NT, mtn, ntn);
    const int b = mt / 33, it = mt % 33;
    const int p0 = it * 126;
    const int row0 = b * SEQ + p0 - 2;
    GTile g, gn;
    g.A = p.hn; g.Bt = p.wt_up; g.lda = DM; g.ldb = DM; g.row0 = row0; g.rlo = b * SEQ; g.rhi = b * SEQ + SEQ - 1; g.col0 = nt * 128;
    {
      const int bn = mtn / 33, itn = mtn % 33;
      gn = g; gn.row0 = bn * SEQ + itn * 126 - 2; gn.rlo = bn * SEQ; gn.rhi = bn * SEQ + SEQ - 1; gn.col0 = ntn * 128;
    }
    f32x4 acc[4][4];
    gemm_mainloop<false>(g, gn, has_next, t == bid, DM, lds, acc);
    asm volatile("s_waitcnt lgkmcnt(0)" ::: "memory");
    __builtin_amdgcn_s_barrier();
    asm volatile("" ::: "memory");
#pragma unroll
    for (int m = 0; m < 4; ++m)
#pragma unroll
      for (int n = 0; n < 2; ++n) {
        const int r = wr * 64 + m * 16 + fr;
        const int c16 = wc * 8 + n * 4 + fq;
        *(f32x4*)(sAct + r * 256 + ((c16 ^ (r & 15)) << 4)) = acc[m][n];
      }
    asm volatile("s_waitcnt lgkmcnt(0)" ::: "memory");
    __builtin_amdgcn_s_barrier();
    asm volatile("" ::: "memory");
#pragma unroll
    for (int n = 0; n < 2; ++n) {
      const int c16 = wc * 8 + n * 4 + fq;
      const int fc = nt * 64 + c16 * 4;
      const f32x4 w0 = *(const f32x4*)(cw + fc), w1 = *(const f32x4*)(cw + DFF + fc), w2 = *(const f32x4*)(cw + 2 * DFF + fc);
      const f32x4 bb = *(const f32x4*)(cb + fc);
#pragma unroll
      for (int m = 0; m < 4; ++m) {
        const int r = wr * 64 + m * 16 + fr;
        const int pos = p0 - 2 + r;
        if (r >= 2 && pos < SEQ) {
          const f32x4 a0 = acc[m][n];
          f32x4 a1 = *(const f32x4*)(sAct + (r - 1) * 256 + ((c16 ^ ((r - 1) & 15)) << 4));
          f32x4 a2 = *(const f32x4*)(sAct + (r - 2) * 256 + ((c16 ^ ((r - 2) & 15)) << 4));
          if (pos < 1) a1 = (f32x4){0.f, 0.f, 0.f, 0.f};
          if (pos < 2) a2 = (f32x4){0.f, 0.f, 0.f, 0.f};
          float hv[4];
#pragma unroll
          for (int j = 0; j < 4; ++j) {
            const float xv = w2[j] * a0[j] + w1[j] * a1[j] + w0[j] * a2[j] + bb[j];
            const float u = 0.7978845608028654f * (xv + 0.044715f * xv * xv * xv);
            const float gl = xv * __builtin_amdgcn_rcpf(1.f + fexp2(-2.f * LOG2E * u));
            hv[j] = gl * acc[m][n + 2][j];
          }
          u32x2 w;
          w.x = pack2(hv[0], hv[1]);
          w.y = pack2(hv[2], hv[3]);
          *(u32x2*)(p.hbuf + (size_t)(b * SEQ + pos) * DFF + fc) = w;
        }
      }
    }
  }
}

__device__ __forceinline__ float wave_sum(float v) {
#pragma unroll
  for (int o = 32; o > 0; o >>= 1) v += __shfl_xor(v, o);
  return v;
}
__device__ __forceinline__ f32x4 ld_mod4(const float* ptr) {
  return ((*(const f32x4*)ptr + *(const f32x4*)(ptr + MOD_PLANE)) + *(const f32x4*)(ptr + 2 * MOD_PLANE)) + *(const f32x4*)(ptr + 3 * MOD_PLANE);
}
__device__ __forceinline__ void rowpass_phase(const float* xsrc, const bf16_t* y, const float* gate, const float* postg, float* xdst,
                              const float* preg, const float* sc, const float* sh, bf16_t* hn, int nb, int bid) {
  const int lane = OTID() & 63, wid = UWID(OTID());
  const int rpw = (NTOK + nb * 4 - 1) / (nb * 4);
  const int rbeg = (bid * 4 + wid) * rpw;
  if (rbeg >= NTOK) return;
  const int rend = rbeg + rpw < NTOK ? rbeg + rpw : NTOK;
  const int b = rbeg >> 12;
  f32x4 vg[4], vpg[4], vpre[4], vsc[4], vsh[4];
#pragma unroll
  for (int i = 0; i < 4; ++i) {
    const int col = i * 256 + lane * 4;
    if (y) { vg[i] = ld_mod4(gate + b * 6144 + col); vpg[i] = *(const f32x4*)(postg + col); }
    if (hn) { vpre[i] = *(const f32x4*)(preg + col); vsc[i] = ld_mod4(sc + b * 6144 + col) + 1.f; vsh[i] = ld_mod4(sh + b * 6144 + col); }
  }
  for (int row0 = rbeg; row0 < rend; row0 += 2) {
    f32x4 xv[2][4];
    u32x2 yr[2][4];
#pragma unroll
    for (int rr = 0; rr < 2; ++rr) {
      const int row = row0 + rr;
      if (row < rend) {
#pragma unroll
        for (int i = 0; i < 4; ++i) xv[rr][i] = __builtin_nontemporal_load((const f32x4*)(xsrc + (size_t)row * DM + i * 256 + lane * 4));
        if (y) {
#pragma unroll
          for (int i = 0; i < 4; ++i) yr[rr][i] = __builtin_nontemporal_load((const u32x2*)(y + (size_t)row * DM + i * 256 + lane * 4));
        }
      }
    }
#pragma unroll
    for (int rr = 0; rr < 2; ++rr) {
      const int row = row0 + rr;
      if (row < rend) {
        if (y) {
          f32x4 yv[4];
          float ss = 0.f;
#pragma unroll
          for (int i = 0; i < 4; ++i) {
            yv[i][0] = __uint_as_float(yr[rr][i].x << 16);
            yv[i][1] = __uint_as_float(yr[rr][i].x & 0xffff0000u);
            yv[i][2] = __uint_as_float(yr[rr][i].y << 16);
            yv[i][3] = __uint_as_float(yr[rr][i].y & 0xffff0000u);
            ss += yv[i][0] * yv[i][0] + yv[i][1] * yv[i][1] + yv[i][2] * yv[i][2] + yv[i][3] * yv[i][3];
          }
          ss = wave_sum(ss);
          const float r = rsqrtf(ss * (1.f / DM) + EPSF);
#pragma unroll
          for (int i = 0; i < 4; ++i) {
            xv[rr][i] = xv[rr][i] + vg[i] * (yv[i] * r) * vpg[i];
            __builtin_nontemporal_store(xv[rr][i], (f32x4*)(xdst + (size_t)row * DM + i * 256 + lane * 4));
          }
        }
        if (hn) {
          float ss = 0.f;
#pragma unroll
          for (int i = 0; i < 4; ++i) ss += xv[rr][i][0] * xv[rr][i][0] + xv[rr][i][1] * xv[rr][i][1] + xv[rr][i][2] * xv[rr][i][2] + xv[rr][i][3] * xv[rr][i][3];
          ss = wave_sum(ss);
          const float r = rsqrtf(ss * (1.f / DM) + EPSF);
#pragma unroll
          for (int i = 0; i < 4; ++i) {
            f32x4 h = (xv[rr][i] * r) * vpre[i] * vsc[i] + vsh[i];
            u32x2 w;
            w.x = pack2(h[0], h[1]);
            w.y = pack2(h[2], h[3]);
            *(u32x2*)(hn + (size_t)row * DM + i * 256 + lane * 4) = w;
          }
        }
      }
    }
  }
}

struct CvtDesc { const float* src; bf16_t* dst; int N, K, k0, ndst0, nsA, nsB; };
__device__ __forceinline__ CvtDesc cvt_decode(KParams& p, int l, int it) {
  const int n_in = 16 * 60, n_out = 16 * 16, n_up = 16 * 88;
  CvtDesc d;
  int i = it;
  if (i < n_in) {
    const int kt = i % 16, ntile = i / 16, ns = ntile * 64;
    d.src = p.w_in + (size_t)l * DM * IN_COLS; d.dst = p.wt_in; d.N = IN_COLS; d.K = DM; d.k0 = kt * 64; d.ndst0 = ns;
    d.nsA = ns < IN_COLS ? ns : -1; d.nsB = ns + 32 < IN_COLS ? ns + 32 : -1;
    return d;
  }
  i -= n_in;
  if (i < n_out) {
    const int kt = i % 16, ntile = i / 16;
    d.src = p.w_out + (size_t)l * DM * DM; d.dst = p.wt_out; d.N = DM; d.K = DM; d.k0 = kt * 64; d.ndst0 = ntile * 64; d.nsA = ntile * 64; d.nsB = ntile * 64 + 32;
    return d;
  }
  i -= n_out;
  if (i < n_up) {
    const int kt = i % 16, q = i / 16;
    const int j = q >> 1, wcv = q & 1;
    d.src = p.w_up + (size_t)l * DM * 2 * DFF; d.dst = p.wt_up; d.N = 2 * DFF; d.K = DM; d.k0 = kt * 64; d.ndst0 = q * 64;
    d.nsA = j * 64 + wcv * 32; d.nsB = DFF + j * 64 + wcv * 32;
    return d;
  }
  i -= n_up;
  {
    const int kt = i % 44, ntile = i / 44;
    d.src = p.w_down + (size_t)l * DFF * DM; d.dst = p.wt_down; d.N = DM; d.K = DFF; d.k0 = kt * 64; d.ndst0 = ntile * 64; d.nsA = ntile * 64; d.nsB = ntile * 64 + 32;
    return d;
  }
}
__device__ __forceinline__ void cvt_load(const CvtDesc& d, int tid, f32x4 (&v)[4]) {
  const int c4 = (tid & 15) * 4, r = tid >> 4;
  const int ns = c4 < 32 ? d.nsA : d.nsB;
  const int sc = ns + (c4 & 31);
  const bool ok = ns >= 0 && sc < d.N;
#pragma unroll
  for (int ps = 0; ps < 4; ++ps) {
    v[ps] = (f32x4){0.f, 0.f, 0.f, 0.f};
    if (ok) v[ps] = __builtin_nontemporal_load((const f32x4*)(d.src + (size_t)(d.k0 + r + 16 * ps) * d.N + sc));
  }
}

__device__ __forceinline__ void convert_weights_phase(KParams& p, int l, unsigned char* lds, int stride, int first, int lo, int hi) {
  float* tiles = (float*)lds;
  const int total = hi;
  const int tid = OTID();
  const int nb = stride, bid = lo + first;
  if (first < 0 || bid >= total) return;
  CvtDesc cur = cvt_decode(p, l, bid);
  f32x4 v[4];
  cvt_load(cur, tid, v);
  int par = 0;
  __syncthreads();
  for (int it = bid; it < total; it += nb) {
    float* tile = tiles + par * (64 * 65);
    {
      const int c4 = (tid & 15) * 4, r = tid >> 4;
#pragma unroll
      for (int ps = 0; ps < 4; ++ps) {
        const int k = r + 16 * ps;
        tile[k * 65 + c4 + 0] = v[ps][0];
        tile[k * 65 + c4 + 1] = v[ps][1];
        tile[k * 65 + c4 + 2] = v[ps][2];
        tile[k * 65 + c4 + 3] = v[ps][3];
      }
    }
    __syncthreads();
    const CvtDesc me = cur;
    if (it + nb < total) { cur = cvt_decode(p, l, it + nb); cvt_load(cur, tid, v); }
    {
      const int n = tid >> 2, kc = (tid & 3) * 16;
      unsigned w[8];
#pragma unroll
      for (int i = 0; i < 8; ++i) w[i] = pack2(tile[(kc + 2 * i) * 65 + n], tile[(kc + 2 * i + 1) * 65 + n]);
      u32x4* dd = (u32x4*)(me.dst + (size_t)(me.ndst0 + n) * me.K + me.k0 + kc);
      dd[0] = (u32x4){w[0], w[1], w[2], w[3]};
      dd[1] = (u32x4){w[4], w[5], w[6], w[7]};
    }
    par ^= 1;
  }
  __syncthreads();
}

__device__ __forceinline__ void mod_phase(KParams& p, unsigned char* lds, int nb, int bid) {
  float* sc_ = (float*)lds;
  float* red = sc_ + 4096;
  const int tid = OTID(), lane = tid & 63, wid = UWID(tid);
  for (int it = bid; it < 192; it += nb) {
    const int l = it / 96, rem = it % 96, cc = (rem >> 2) * 256, kq = rem & 3;
    __syncthreads();
    {
      f32x4 cv[4];
#pragma unroll
      for (int j = 0; j < 4; ++j) cv[j] = *(const f32x4*)(p.c + tid * 16 + j * 4);
#pragma unroll
      for (int j = 0; j < 4; ++j) {
        f32x4 r;
        r[0] = siluf(cv[j][0]); r[1] = siluf(cv[j][1]); r[2] = siluf(cv[j][2]); r[3] = siluf(cv[j][3]);
        *(f32x4*)(sc_ + tid * 16 + j * 4) = r;
      }
    }
    __syncthreads();
    const float* w = p.ada_w + (size_t)l * DM * 6144 + cc + lane * 4;
    f32x4 a0 = (f32x4){0.f, 0.f, 0.f, 0.f}, a1 = a0, a2 = a0, a3 = a0;
    const int kb = kq * 256 + wid * 64;
#pragma unroll 32
    for (int k = kb; k < kb + 64; ++k) {
      const f32x4 wv = __builtin_nontemporal_load((const f32x4*)(w + (size_t)k * 6144));
      a0 += wv * sc_[k];
      a1 += wv * sc_[1024 + k];
      a2 += wv * sc_[2048 + k];
      a3 += wv * sc_[3072 + k];
    }
    *(f32x4*)(red + (wid * 4 + 0) * 256 + lane * 4) = a0;
    *(f32x4*)(red + (wid * 4 + 1) * 256 + lane * 4) = a1;
    *(f32x4*)(red + (wid * 4 + 2) * 256 + lane * 4) = a2;
    *(f32x4*)(red + (wid * 4 + 3) * 256 + lane * 4) = a3;
    __syncthreads();
    {
      const int b = wid;
      f32x4 sv = (*(const f32x4*)(red + (0 * 4 + b) * 256 + lane * 4) + *(const f32x4*)(red + (1 * 4 + b) * 256 + lane * 4)) +
                 (*(const f32x4*)(red + (2 * 4 + b) * 256 + lane * 4) + *(const f32x4*)(red + (3 * 4 + b) * 256 + lane * 4));
      if (kq == 0) sv += *(const f32x4*)(p.ada_b + (size_t)l * 6144 + cc + lane * 4);
      *(f32x4*)(p.mod + (size_t)kq * MOD_PLANE + (size_t)(l * 4 + b) * 6144 + cc + lane * 4) = sv;
    }
  }
}

__device__ __forceinline__ void sb_item(KParams& p, int b, int h, int qt, unsigned char* lds) {
  bf16_t* sK = (bf16_t*)lds;
  bf16_t* sV = sK + 64 * LSTR;
  volatile int* sFlag = (volatile int*)(sV + 64 * LSTR);
  const int tid = OTID(), lane = tid & 63, wid = UWID(tid), fr = lane & 15, fq = lane >> 4;
  const int sr = tid >> 3, sc8 = (tid & 7) * 8;
  const size_t tokq = (size_t)b * SEQ + qt * 64 + wid * 16 + fr;
  bf16x8 qf[2];
#pragma unroll
  for (int ks = 0; ks < 2; ++ks) qf[ks] = *(const bf16x8*)(p.sq + tokq * 384 + h * 64 + ks * 32 + fq * 8);
  f32x4 o[4];
#pragma unroll
  for (int n = 0; n < 4; ++n) o[n] = (f32x4){0.f, 0.f, 0.f, 0.f};
  float carry = 0.f;
  const int tq = qt * 64 + wid * 16 + fr;
  const bf16_t* kbase = p.sk + ((size_t)b * SEQ) * 384 + h * 64 + sc8;
  const bf16_t* vbase = p.svt + ((size_t)(b * 6 + h) * 64) * SEQ + sc8;
  u32x4 kreg[2], vreg[2];
#pragma unroll
  for (int i = 0; i < 2; ++i) {
    kreg[i] = *(const u32x4*)(kbase + (size_t)(qt * 64 + sr + 32 * i) * 384);
    vreg[i] = *(const u32x4*)(vbase + (size_t)(sr + 32 * i) * SEQ + qt * 64);
  }
  __syncthreads();
  for (int kt = qt; kt >= 0; --kt) {
#pragma unroll
    for (int i = 0; i < 2; ++i) {
      *(u32x4*)(sK + (sr + 32 * i) * LSTR + sc8) = kreg[i];
      *(u32x4*)(sV + (sr + 32 * i) * LSTR + sc8) = vreg[i];
    }
    __syncthreads();
    if (kt > 0) {
#pragma unroll
      for (int i = 0; i < 2; ++i) {
        kreg[i] = *(const u32x4*)(kbase + (size_t)((kt - 1) * 64 + sr + 32 * i) * 384);
        vreg[i] = *(const u32x4*)(vbase + (size_t)(sr + 32 * i) * SEQ + (kt - 1) * 64);
      }
    }
    f32x4 z[4];
#pragma unroll
    for (int m = 0; m < 4; ++m) {
      z[m] = (f32x4){0.f, 0.f, 0.f, 0.f};
#pragma unroll
      for (int ks = 0; ks < 2; ++ks) {
        const bf16x8 kf = *(const bf16x8*)(sK + (m * 16 + fr) * LSTR + ks * 32 + fq * 8);
        z[m] = mfma16(kf, qf[ks], z[m]);
      }
    }
    float lk[4][4], lb[4][4];
    const bool diag = (kt == qt);
#pragma unroll
    for (int m = 0; m < 4; ++m)
#pragma unroll
      for (int j = 0; j < 4; ++j) {
        const float zz = z[m][j];
        const float sp = fmaxf(zz, 0.f) + flog2(1.f + fexp2(-fabsf(zz)));
        const int s = kt * 64 + m * 16 + fq * 4 + j;
        const bool valid = (!diag) || (s < tq);
        lk[m][j] = valid ? -sp : 0.f;
        lb[m][j] = valid ? (zz - sp) : -1e30f;
      }
    float tot[4], ex[4];
#pragma unroll
    for (int m = 0; m < 4; ++m) {
      const float s4 = (lk[m][0] + lk[m][1]) + (lk[m][2] + lk[m][3]);
      const float bb = __shfl_xor(s4, 16);
      const float cc = s4 + bb;
      const float dd = __shfl_xor(cc, 32);
      tot[m] = cc + dd;
      ex[m] = ((fq & 1) ? 0.f : bb) + ((fq & 2) ? 0.f : dd);
    }
    float a[4][4];
    float base = carry;
#pragma unroll
    for (int m = 3; m >= 0; --m) {
      float run = base + ex[m];
#pragma unroll
      for (int j = 3; j >= 0; --j) {
        a[m][j] = fexp2(lb[m][j] + run);
        run += lk[m][j];
      }
      base += tot[m];
    }
    carry = base;
#pragma unroll
    for (int u = 0; u < 2; ++u) {
      U4B8 pa;
      pa.u.x = pack2(a[2 * u][0], a[2 * u][1]);
      pa.u.y = pack2(a[2 * u][2], a[2 * u][3]);
      pa.u.z = pack2(a[2 * u + 1][0], a[2 * u + 1][1]);
      pa.u.w = pack2(a[2 * u + 1][2], a[2 * u + 1][3]);
#pragma unroll
      for (int n = 0; n < 4; ++n) {
        U2x2B8 vf;
        vf.u[0] = *(const u32x2*)(sV + (n * 16 + fr) * LSTR + u * 32 + fq * 4);
        vf.u[1] = *(const u32x2*)(sV + (n * 16 + fr) * LSTR + u * 32 + 16 + fq * 4);
        o[n] = mfma16(pa.v, vf.v, o[n]);
      }
    }
    {
      const int wdone = __all(carry < -180.f) ? 1 : 0;
      if (lane == 0) sFlag[wid] = wdone;
      __syncthreads();
      if (sFlag[0] & sFlag[1] & sFlag[2] & sFlag[3]) break;
    }
  }
  bf16_t* ob = p.hn + ((size_t)b * SEQ + qt * 64 + wid * 16) * DM + 384 + h * 64;
#pragma unroll
  for (int n = 0; n < 4; ++n)
#pragma unroll
    for (int j = 0; j < 4; ++j) ob[(size_t)(fq * 4 + j) * DM + n * 16 + fr] = f2bf(o[n][j]);
}

__device__ __forceinline__ void lin_prep(KParams& p, int l, int b, int g, int ic, float (&bc)[16], float& blast, float* sGlr, float* sTot) {
  const int tid = OTID(), lane = tid & 63, wid = UWID(tid);
  if (g < 6) {
    const float lg = LOG_GAMMA[g];
#pragma unroll
    for (int r = 0; r < 16; ++r) bc[r] = (float)(16 * wid + r + 1) * lg;
    blast = 64.f * lg;
  } else {
    const size_t T0 = (size_t)b * SEQ + ic * 64;
    *(f32x4*)(sGlr + tid * 4) = *(const f32x4*)(p.glr + T0 * 16 + tid * 4);
    const int c = (g - 6) * 64 + lane;
    float w2r[16];
#pragma unroll
    for (int rr = 0; rr < 16; ++rr) w2r[rr] = p.gla_w2[((size_t)l * 16 + rr) * 256 + c];
    const float gb = p.gla_b[(size_t)l * 256 + c];
    __syncthreads();
    float run = 0.f;
#pragma unroll
    for (int r = 0; r < 16; ++r) {
      const int t = 16 * wid + r;
      float xv = gb;
#pragma unroll
      for (int rr = 0; rr < 16; ++rr) xv += sGlr[t * 16 + rr] * w2r[rr];
      const float ls = -(fmaxf(-xv, 0.f) + __logf(1.f + __expf(-fabsf(xv))));
      run += ls * (1.f / 16.f);
      bc[r] = run;
    }
    sTot[wid * 64 + lane] = run;
    __syncthreads();
    float off = 0.f, tt = 0.f;
#pragma unroll
    for (int w = 0; w < 4; ++w) {
      const float v = sTot[w * 64 + lane];
      tt += v;
      if (w < wid) off += v;
    }
#pragma unroll
    for (int r = 0; r < 16; ++r) bc[r] += off;
    blast = tt;
  }
}

__device__ __forceinline__ void lin_kv_item(KParams& p, int l, int b, int g, int ic, unsigned char* lds) {
  bf16_t* sKT = (bf16_t*)lds;
  bf16_t* sV = sKT + 64 * LSTR;
  float* sGlr = (float*)(sV + 64 * LSTR);
  float* sTot = sGlr + 1024;
  const int tid = OTID(), lane = tid & 63, wid = UWID(tid), fr = lane & 15, fq = lane >> 4;
  const int bg = b * 10 + g;
  const size_t T0 = (size_t)b * SEQ + ic * 64;
  __syncthreads();
  bf16_t kraw[16];
  u32x4 vreg[2];
  {
#pragma unroll
    for (int r = 0; r < 16; ++r) kraw[r] = p.lk[(T0 + 16 * wid + r) * 640 + g * 64 + lane];
    const int sr = tid >> 3, sc8 = (tid & 7) * 8;
#pragma unroll
    for (int i = 0; i < 2; ++i) vreg[i] = *(const u32x4*)(p.lvt + ((size_t)bg * 64 + sr + 32 * i) * SEQ + ic * 64 + sc8);
  }
  float bc[16], blast;
  lin_prep(p, l, b, g, ic, bc, blast, sGlr, sTot);
  {
    unsigned w[8];
#pragma unroll
    for (int r = 0; r < 16; r += 2) {
      const float k0 = bf2f(kraw[r]);
      const float k1 = bf2f(kraw[r + 1]);
      w[r >> 1] = pack2(k0 * __expf(blast - bc[r]), k1 * __expf(blast - bc[r + 1]));
    }
    u32x4* d = (u32x4*)(sKT + lane * LSTR + 16 * wid);
    d[0] = (u32x4){w[0], w[1], w[2], w[3]};
    d[1] = (u32x4){w[4], w[5], w[6], w[7]};
  }
  {
    const int sr = tid >> 3, sc8 = (tid & 7) * 8;
#pragma unroll
    for (int i = 0; i < 2; ++i) *(u32x4*)(sV + (sr + 32 * i) * LSTR + sc8) = vreg[i];
  }
  __syncthreads();
  float* kvo = p.kvt + ((size_t)bg * 64 + ic) * 4096;
#pragma unroll
  for (int ne = 0; ne < 4; ++ne) {
    f32x4 acc = (f32x4){0.f, 0.f, 0.f, 0.f};
#pragma unroll
    for (int ks = 0; ks < 2; ++ks) {
      const bf16x8 af = *(const bf16x8*)(sKT + (wid * 16 + fr) * LSTR + ks * 32 + fq * 8);
      const bf16x8 bf = *(const bf16x8*)(sV + (ne * 16 + fr) * LSTR + ks * 32 + fq * 8);
      acc = mfma16(af, bf, acc);
    }
    *(f32x4*)(kvo + (ne * 16 + fr) * 64 + wid * 16 + fq * 4) = acc;
  }
  if (wid == 0) p.bl[((size_t)bg * 64 + ic) * 64 + lane] = blast;
}

__device__ __forceinline__ void lin_scan_phase(KParams& p, int nb, int bid) {
  const int tid = OTID();
  const int total = 40 * 4096;
  const int per = (total + nb - 1) / nb;
  const int lo = bid * per, hi = lo + per < total ? lo + per : total;
  for (int base = lo; base < hi; base += 512) {
    const int e0 = base + tid, e1 = base + 256 + tid;
    const bool a0 = e0 < hi, a1 = e1 < hi;
    const int ee0 = a0 ? e0 : lo, ee1 = a1 ? e1 : lo;
    const int bg0 = ee0 >> 12, bg1 = ee1 >> 12;
    const int i0x = ee0 & 4095, i1x = ee1 & 4095;
    const float* kv0 = p.kvt + (size_t)bg0 * 64 * 4096 + i0x;
    const float* kv1 = p.kvt + (size_t)bg1 * 64 * 4096 + i1x;
    const float* bl0 = p.bl + (size_t)bg0 * 64 * 64 + (i0x & 63);
    const float* bl1 = p.bl + (size_t)bg1 * 64 * 64 + (i1x & 63);
    bf16_t* so0 = p.st + (size_t)bg0 * 64 * 4096 + i0x;
    bf16_t* so1 = p.st + (size_t)bg1 * 64 * 4096 + i1x;
    float s0 = 0.f, s1 = 0.f;
#pragma nounroll
    for (int c0 = 0; c0 < 64; c0 += 16) {
      float kva[16], da[16], kvb[16], db[16];
#pragma unroll
      for (int i = 0; i < 16; ++i) {
        kva[i] = __builtin_nontemporal_load(kv0 + (size_t)(c0 + i) * 4096);
        da[i] = bl0[(c0 + i) * 64];
      }
      if (a1) {
#pragma unroll
        for (int i = 0; i < 16; ++i) {
          kvb[i] = __builtin_nontemporal_load(kv1 + (size_t)(c0 + i) * 4096);
          db[i] = bl1[(c0 + i) * 64];
        }
      }
      if (a0) {
#pragma unroll
        for (int i = 0; i < 16; ++i) {
          so0[(size_t)(c0 + i) * 4096] = f2bf(s0);
          s0 = __expf(da[i]) * s0 + kva[i];
        }
      }
      if (a1) {
#pragma unroll
        for (int i = 0; i < 16; ++i) {
          so1[(size_t)(c0 + i) * 4096] = f2bf(s1);
          s1 = __expf(db[i]) * s1 + kvb[i];
        }
      }
    }
  }
}

__device__ __forceinline__ void lin_out_item(KParams& p, int l, int b, int g, int ic, unsigned char* lds) {
  bf16_t* sQp = (bf16_t*)lds;
  bf16_t* sQm = sQp + 64 * LSTR;
  bf16_t* sKp = sQm + 64 * LSTR;
  bf16_t* sKm = sKp + 64 * LSTR;
  bf16_t* sV = sKm + 64 * LSTR;
  bf16_t* sS = sV + 64 * LSTR;
  float* sGlr = (float*)(sS + 64 * LSTR);
  float* sTot = sGlr + 1024;
  const int tid = OTID(), lane = tid & 63, wid = UWID(tid), fr = lane & 15, fq = lane >> 4;
  const int bg = b * 10 + g;
  const size_t T0 = (size_t)b * SEQ + ic * 64;
  __syncthreads();
  bf16_t qraw[16], kraw[16];
  u32x4 vreg[2], sreg[2];
  {
#pragma unroll
    for (int r = 0; r < 16; ++r) {
      qraw[r] = p.lq[(T0 + 16 * wid + r) * 640 + g * 64 + lane];
      kraw[r] = p.lk[(T0 + 16 * wid + r) * 640 + g * 64 + lane];
    }
    const int sr = tid >> 3, sc8 = (tid & 7) * 8;
#pragma unroll
    for (int i = 0; i < 2; ++i) {
      vreg[i] = *(const u32x4*)(p.lvt + ((size_t)bg * 64 + sr + 32 * i) * SEQ + ic * 64 + sc8);
      sreg[i] = __builtin_nontemporal_load((const u32x4*)(p.st + ((size_t)bg * 64 + ic) * 4096 + (sr + 32 * i) * 64 + sc8));
    }
  }
  float bc[16], blast;
  lin_prep(p, l, b, g, ic, bc, blast, sGlr, sTot);
#pragma unroll
  for (int r = 0; r < 16; ++r) {
    const int t = 16 * wid + r;
    const float qv = bf2f(qraw[r]);
    const float kv = bf2f(kraw[r]);
    const float ep = __expf(bc[r]), em = __expf(-bc[r]);
    sQp[t * LSTR + lane] = f2bf(qv * ep);
    sQm[t * LSTR + lane] = f2bf(qv * em);
    sKp[t * LSTR + lane] = f2bf(kv * ep);
    sKm[t * LSTR + lane] = f2bf(kv * em);
  }
  {
    const int sr = tid >> 3, sc8 = (tid & 7) * 8;
#pragma unroll
    for (int i = 0; i < 2; ++i) {
      *(u32x4*)(sV + (sr + 32 * i) * LSTR + sc8) = vreg[i];
      *(u32x4*)(sS + (sr + 32 * i) * LSTR + sc8) = sreg[i];
    }
  }
  __syncthreads();
  bf16x8 qpf[2], qmf[2];
#pragma unroll
  for (int ks = 0; ks < 2; ++ks) {
    qpf[ks] = *(const bf16x8*)(sQp + (wid * 16 + fr) * LSTR + ks * 32 + fq * 8);
    qmf[ks] = *(const bf16x8*)(sQm + (wid * 16 + fr) * LSTR + ks * 32 + fq * 8);
  }
  float P[4][4];
#pragma unroll
  for (int ms = 0; ms < 4; ++ms) {
    f32x4 lo = (f32x4){0.f, 0.f, 0.f, 0.f}, up = (f32x4){0.f, 0.f, 0.f, 0.f};
#pragma unroll
    for (int ks = 0; ks < 2; ++ks) {
      const bf16x8 kmf = *(const bf16x8*)(sKm + (ms * 16 + fr) * LSTR + ks * 32 + fq * 8);
      const bf16x8 kpf = *(const bf16x8*)(sKp + (ms * 16 + fr) * LSTR + ks * 32 + fq * 8);
      lo = mfma16(kmf, qpf[ks], lo);
      up = mfma16(kpf, qmf[ks], up);
    }
#pragma unroll
    for (int j = 0; j < 4; ++j) {
      const int s = ms * 16 + fq * 4 + j, t = wid * 16 + fr;
      P[ms][j] = (t >= s) ? lo[j] : up[j];
    }
  }
  f32x4 o[4];
#pragma unroll
  for (int ne = 0; ne < 4; ++ne) o[ne] = (f32x4){0.f, 0.f, 0.f, 0.f};
#pragma unroll
  for (int u = 0; u < 2; ++u) {
    U4B8 pa;
    pa.u.x = pack2(P[2 * u][0], P[2 * u][1]);
    pa.u.y = pack2(P[2 * u][2], P[2 * u][3]);
    pa.u.z = pack2(P[2 * u + 1][0], P[2 * u + 1][1]);
    pa.u.w = pack2(P[2 * u + 1][2], P[2 * u + 1][3]);
#pragma unroll
    for (int ne = 0; ne < 4; ++ne) {
      U2x2B8 vf;
      vf.u[0] = *(const u32x2*)(sV + (ne * 16 + fr) * LSTR + u * 32 + fq * 4);
      vf.u[1] = *(const u32x2*)(sV + (ne * 16 + fr) * LSTR + u * 32 + 16 + fq * 4);
      o[ne] = mfma16(pa.v, vf.v, o[ne]);
    }
  }
#pragma unroll
  for (int ks = 0; ks < 2; ++ks)
#pragma unroll
    for (int ne = 0; ne < 4; ++ne) {
      const bf16x8 sf = *(const bf16x8*)(sS + (ne * 16 + fr) * LSTR + ks * 32 + fq * 8);
      o[ne] = mfma16(qpf[ks], sf, o[ne]);
    }
  const bool isret = (g < 6);
  const float* gam = isret ? (p.ret_norm_g + (size_t)l * 384 + g * 64) : (p.gla_norm_g + (size_t)l * 256 + (g - 6) * 64);
  const int mixcol = isret ? g * 64 : 768 + (g - 6) * 64;
#pragma unroll
  for (int j = 0; j < 4; ++j) {
    float s1 = (o[0][j] + o[1][j]) + (o[2][j] + o[3][j]);
#pragma unroll
    for (int of = 8; of > 0; of >>= 1) s1 += __shfl_xor(s1, of);
    const float mu = isret ? s1 * (1.f / 64.f) : 0.f;
    float s2 = 0.f;
#pragma unroll
    for (int ne = 0; ne < 4; ++ne) { const float dv = o[ne][j] - mu; s2 += dv * dv; }
#pragma unroll
    for (int of = 8; of > 0; of >>= 1) s2 += __shfl_xor(s2, of);
    const float rs = rsqrtf(s2 * (1.f / 64.f) + EPSF);
    const size_t tok = T0 + wid * 16 + fq * 4 + j;
#pragma unroll
    for (int ne = 0; ne < 4; ++ne) {
      const int e = ne * 16 + fr;
      const float gate = bf2f(p.lg[tok * 640 + g * 64 + e]);
      p.hn[tok * DM + mixcol + e] = f2bf((o[ne][j] - mu) * rs * gam[e] * gate);
    }
  }
}

__device__ __forceinline__ void run_phase(KParams& p, int ph, int l, unsigned char* lds, int nb, int bid) {
  const float* modl = p.mod + (size_t)l * 4 * 6144;
  switch (ph) {
    case 0:
      {
        const int CT = 16 * 60 + 16 * 16 + 16 * 88 + 44 * 16;
        const int nmod = nb > 192 ? 192 : 0;
        const int partA = nmod ? 7 * (nb - nmod) : 0;
        if (nmod == 0 || bid < nmod) mod_phase(p, lds, nb, bid);
        else convert_weights_phase(p, 0, lds, nb - nmod, bid - nmod, 0, partA < CT ? partA : CT);
        if (partA < CT) convert_weights_phase(p, 0, lds, nb, bid, partA, CT);
      }
      break;
    case 1:
      rowpass_phase(p.x, nullptr, nullptr, nullptr, nullptr, p.pre_mix_g, p.mod + 1024, p.mod, p.hn, nb, bid);
      break;
    case 2:
      proj_phase(p, l, lds, nb, bid);
      break;
    case 3:
      for (int it = bid; it < 2560; it += nb) lin_kv_item(p, l, it / 640, (it / 64) % 10, it & 63, lds);
      break;
    case 4:
      lin_scan_phase(p, nb, bid);
      break;
    case 5:
      for (int it = bid; it < 1536 + 2560; it += nb) {
        if (it < 1536) {
          sb_item(p, (it % 24) / 6, it % 6, 63 - it / 24, lds);
        } else {
          const int i2 = it - 1536;
          lin_out_item(p, l, i2 / 640, (i2 / 64) % 10, i2 & 63, lds);
        }
      }
      break;
    case 6:
      gemm_y_phase(p, p.hn, DM, p.wt_out, lds, nb, bid);
      break;
    case 7:
      rowpass_phase(l == 0 ? p.x : p.out, p.y, modl + 2048, p.post_mix_g + (size_t)l * DM, p.out, p.pre_ffn_g + (size_t)l * DM,
                    modl + 4096, modl + 3072, p.hn, nb, bid);
      break;
    case 8:
      up_phase(p, l, lds, nb, bid);
      break;
    case 9:
      gemm_y_phase(p, p.hbuf, DFF, p.wt_down, lds, nb, bid);
      break;
    case 10:
      if (l == 0) {
        rowpass_phase(p.out, p.y, modl + 5120, p.post_ffn_g, p.out, p.pre_mix_g + DM, p.mod + 4 * 6144 + 1024, p.mod + 4 * 6144, p.hn, nb, bid);
        convert_weights_phase(p, 1, lds, nb, bid, 0, 16 * 60 + 16 * 16 + 16 * 88 + 44 * 16);
      } else {
        rowpass_phase(p.out, p.y, modl + 5120, p.post_ffn_g + DM, p.out, nullptr, nullptr, nullptr, nullptr, nb, bid);
      }
      break;
  }
}


#define XB_TMO      128
#define XB_XCNT(j)  (256  + 64 * (j))
#define XB_XSUB(j)  (1280 + 64 * (j))
#define XB_XGEN(j)  (2304 + 64 * (j))
#define XB_TOP      3328
#define XB_TOPGEN   3392
#define XCD_BAR_WORDS 3456
#define XB_SPIN_CAP (1u << 20)
#define LAS __attribute__((address_space(3)))
__device__ __forceinline__ unsigned xb_ld(unsigned* p)              { return __hip_atomic_load(p, __ATOMIC_RELAXED, __HIP_MEMORY_SCOPE_AGENT); }
__device__ __forceinline__ unsigned xb_add(unsigned* p, unsigned v) { return __hip_atomic_fetch_add(p, v, __ATOMIC_RELAXED, __HIP_MEMORY_SCOPE_AGENT); }
__device__ __forceinline__ unsigned xb_xcc_id() { return (unsigned)__builtin_amdgcn_s_getreg((3 << 11) | 20) & 0xFu; }
#define XB_SPIN(cond, bar) do { unsigned _sp = 0; while (cond) { __builtin_amdgcn_s_sleep(1); \
    if ((++_sp & 255u) == 0u) { if (xb_ld(&(bar)[XB_TMO])) break; if (_sp > XB_SPIN_CAP) { atomicAdd(&(bar)[XB_TMO], 1u); break; } } } } while (0)
struct XcdBarrier { unsigned* bar; unsigned x; volatile LAS unsigned* st; };
__device__ __forceinline__ XcdBarrier xcd_barrier_post(unsigned* bar, volatile LAS unsigned* st) {
    XcdBarrier b; b.bar = bar; b.x = xb_xcc_id(); b.st = st;
    if (threadIdx.x == 0) (void)xb_add(&bar[XB_XCNT(b.x)], 1u);
    return b;
}
__device__ __forceinline__ void xcd_barrier_complete(unsigned* bar, unsigned x, unsigned& nloc, unsigned& nx) {
    const unsigned G = gridDim.x * gridDim.y * gridDim.z;
    unsigned sum, cnt, mine, sp = 0u;
    for (;;) {
        sum = 0u; cnt = 0u; mine = 0u;
#pragma unroll
        for (unsigned j = 0; j < 16; ++j) { const unsigned c = xb_ld(&bar[XB_XCNT(j)]); sum += c; cnt += (c > 0u) ? 1u : 0u; mine = (j == x) ? c : mine; }
        if (sum == G) break;
        __builtin_amdgcn_s_sleep(1);
        if ((++sp & 255u) == 0u) { if (xb_ld(&bar[XB_TMO])) break; if (sp > XB_SPIN_CAP) { atomicAdd(&bar[XB_TMO], 1u); break; } }
    }
    nloc = mine > 0u ? mine : 1u; nx = cnt > 0u ? cnt : 1u;
}
__device__ __forceinline__ void xcd_barrier(const XcdBarrier& b) {
    asm volatile("s_waitcnt vmcnt(0)" ::: "memory");
    __syncthreads();
    if (threadIdx.x == 0) {
        unsigned* bar = b.bar;
        __builtin_amdgcn_s_waitcnt(0);
        unsigned nloc = b.st[0], nx = b.st[1];
        if (nloc == 0u) { xcd_barrier_complete(bar, b.x, nloc, nx); b.st[0] = nloc; b.st[1] = nx; }
        const unsigned old = xb_add(&bar[XB_XSUB(b.x)], 1u);
        const unsigned gen = old / nloc;
        if (old + 1u == (gen + 1u) * nloc) {
            __builtin_amdgcn_fence(__ATOMIC_RELEASE, "agent");
            asm volatile("s_waitcnt vmcnt(0)" ::: "memory");
            const unsigned og = xb_add(&bar[XB_TOP], 1u);
            const unsigned tg = og / nx;
            if (og + 1u == (tg + 1u) * nx) xb_add(&bar[XB_TOPGEN], 1u);
            else XB_SPIN(xb_ld(&bar[XB_TOPGEN]) == tg, bar);
            __builtin_amdgcn_fence(__ATOMIC_ACQUIRE, "agent");
            xb_add(&bar[XB_XGEN(b.x)], 1u);
            asm volatile("s_waitcnt vmcnt(0)" ::: "memory");
        } else {
            XB_SPIN(xb_ld(&bar[XB_XGEN(b.x)]) == gen, bar);
            __builtin_amdgcn_fence(__ATOMIC_ACQUIRE, "agent");
            asm volatile("s_waitcnt vmcnt(0)" ::: "memory");
        }
    }
    __syncthreads();
}

__global__ void __launch_bounds__(256, 2) mega_kernel(Params p) {
  __shared__ __attribute__((aligned(16))) unsigned char lds[LDS_BYTES + 16];
  cg::grid_group grid = cg::this_grid();
  const int nb = gridDim.x, bid = blockIdx.x;
  volatile LAS unsigned* st = (volatile LAS unsigned*)(lds + LDS_BYTES);
  if (threadIdx.x < 4) st[threadIdx.x] = 0u;
  __syncthreads();
  if (p.x == nullptr) grid.sync();
  XcdBarrier xb = xcd_barrier_post(p.bar, st);
  for (int step = 0; step < 20; ++step) {
    const int l = step >= 11 ? 1 : 0;
    const int ph = step < 2 ? step : (step >= 11 ? step - 9 : step);
    int nb_ = nb, bid_ = bid;
    KParams* kp = (KParams*)__builtin_amdgcn_kernarg_segment_ptr();
    asm volatile("" : "+s"(nb_), "+s"(bid_), "+s"(kp));
    run_phase(*kp, ph, l, lds, nb_, bid_);
    if (step < 19) xcd_barrier(xb);
  }
}

extern "C" void kernel_launch(void* const* d_in, const int* in_sizes, int n_in, void* d_out, int out_size, void* d_ws,
                              size_t ws_size, hipStream_t stream) {
  Params p{};
  p.x = (const float*)d_in[0];
  p.c = (const float*)d_in[1];
  p.ada_w = (const float*)d_in[2];
  p.ada_b = (const float*)d_in[3];
  p.pre_mix_g = (const float*)d_in[4];
  p.post_mix_g = (const float*)d_in[5];
  p.w_in = (const float*)d_in[6];
  p.gla_w2 = (const float*)d_in[7];
  p.gla_b = (const float*)d_in[8];
  p.ret_norm_g = (const float*)d_in[9];
  p.gla_norm_g = (const float*)d_in[10];
  p.w_out = (const float*)d_in[11];
  p.pre_ffn_g = (const float*)d_in[12];
  p.post_ffn_g = (const float*)d_in[13];
  p.w_up = (const float*)d_in[14];
  p.conv_w = (const float*)d_in[15];
  p.conv_b = (const float*)d_in[16];
  p.w_down = (const float*)d_in[17];
  p.out = (float*)d_out;
  unsigned char* ws = (unsigned char*)d_ws;
  size_t off = 0;
  p.wt_in = (bf16_t*)(ws + off); off += (size_t)IN_PAD * DM * 2;
  p.wt_out = (bf16_t*)(ws + off); off += (size_t)DM * DM * 2;
  p.wt_up = (bf16_t*)(ws + off); off += (size_t)2 * DFF * DM * 2;
  p.wt_down = (bf16_t*)(ws + off); off += (size_t)DM * DFF * 2;
  p.mod = (float*)(ws + off); off += (size_t)4 * MOD_PLANE * 4;
  p.hn = (bf16_t*)(ws + off); off += (size_t)NTOK * DM * 2;
  const size_t r1 = off;
  p.lq = (bf16_t*)(ws + off); off += (size_t)NTOK * 640 * 2;
  p.lk = (bf16_t*)(ws + off); off += (size_t)NTOK * 640 * 2;
  p.lvt = (bf16_t*)(ws + off); off += (size_t)NTOK * 640 * 2;
  p.lg = (bf16_t*)(ws + off); off += (size_t)NTOK * 640 * 2;
  p.sq = (bf16_t*)(ws + off); off += (size_t)NTOK * 384 * 2;
  p.sk = (bf16_t*)(ws + off); off += (size_t)NTOK * 384 * 2;
  p.svt = (bf16_t*)(ws + off); off += (size_t)NTOK * 384 * 2;
  p.glr = (float*)(ws + off); off += (size_t)NTOK * 16 * 4;
  p.hbuf = (bf16_t*)(ws + r1);
  const size_t r2 = off;
  p.y = (bf16_t*)(ws + r2);
  p.kvt = (float*)(ws + r2);
  p.st = (bf16_t*)(ws + r2 + (size_t)40 * 64 * 4096 * 4);
  p.bl = (float*)(ws + r2 + (size_t)40 * 64 * 4096 * 4 + (size_t)40 * 64 * 4096 * 2);
  off += (size_t)NTOK * DM * 4;
  p.bar = (unsigned*)(ws + off); off += 16384;
  if (off > ws_size) { fprintf(stderr, "workspace too small: need %zu have %zu\n", off, ws_size); return; }

  static int grid_blocks = 0;
  if (!grid_blocks) {
    int dev = 0, cus = 0, per_cu = 0;
    hipGetDevice(&dev);
    hipDeviceGetAttribute(&cus, hipDeviceAttributeMultiprocessorCount, dev);
    hipOccupancyMaxActiveBlocksPerMultiprocessor(&per_cu, mega_kernel, 256, 0);
    if (per_cu > 2) per_cu = 2;
    if (per_cu < 1) per_cu = 1;
    grid_blocks = cus * per_cu;
  }
  (void)hipMemsetAsync(p.bar, 0, 16384, stream);
  void* args[] = {&p};
  hipError_t e = hipLaunchCooperativeKernel((void*)mega_kernel, dim3(grid_blocks), dim3(256), args, 0, stream);
  if (e != hipSuccess) fprintf(stderr, "cooperative launch failed: %s (grid %d)\n", hipGetErrorString(e), grid_blocks);
}
```

```cpp
#include <hip/hip_runtime.h>
#include <hip/hip_cooperative_groups.h>
#include <cstdio>
#include <cstdint>
namespace cg = cooperative_groups;

#ifndef DUPMASK
#define DUPMASK 0
#endif
#ifndef MODE_MULTI
#define MODE_MULTI 0
#endif

typedef unsigned short bf16_t;
typedef short bf16x8 __attribute__((ext_vector_type(8)));
typedef float f32x4 __attribute__((ext_vector_type(4)));
typedef unsigned u32x4 __attribute__((ext_vector_type(4)));
typedef unsigned u32x2 __attribute__((ext_vector_type(2)));

#define NTOK 16384
#define SEQ 4096
#define DM 1024
#define IN_COLS 3728
#define IN_PAD 3840
#define DFF 2816
#define LSTR 72
#define LDS_BYTES 65536
#define EPSF 1e-6f
#define LOG2E 1.4426950408889634f
#define MOD_PLANE (2 * 4 * 6144)

struct Params {
  const float *x, *c, *ada_w, *ada_b, *pre_mix_g, *post_mix_g, *w_in, *gla_w2, *gla_b, *ret_norm_g, *gla_norm_g,
      *w_out, *pre_ffn_g, *post_ffn_g, *w_up, *conv_w, *conv_b, *w_down;
  float* out;
  bf16_t *wt_in, *wt_out, *wt_up, *wt_down;
  float* mod;
  bf16_t* hn;
  bf16_t *lq, *lk, *lvt, *lg, *sq, *sk, *svt;
  float* glr;
  bf16_t* hbuf;
  bf16_t* y;
  float* kvt;
  bf16_t* st;
  float* bl;
  unsigned* bar;
};
typedef const __attribute__((address_space(4))) Params KParams;

__constant__ float ROPE_HI[32] = {1.591549367e-01f, 1.193493679e-01f, 8.949939907e-02f, 6.711508334e-02f, 5.032921210e-02f, 3.774158657e-02f, 2.830219641e-02f, 2.122365311e-02f, 1.591549441e-02f, 1.193493698e-02f, 8.949940093e-03f, 6.711508147e-03f, 5.032921210e-03f, 3.774158424e-03f, 2.830219688e-03f, 2.122365171e-03f, 1.591549488e-03f, 1.193493721e-03f, 8.949940093e-04f, 6.711508031e-04f, 5.032921326e-04f, 3.774158540e-04f, 2.830219455e-04f, 2.122365258e-04f, 1.591549371e-04f, 1.193493736e-04f, 8.949940093e-05f, 6.711508468e-05f, 5.032921035e-05f, 3.774158540e-05f, 2.830219637e-05f, 2.122365186e-05f};
__constant__ float ROPE_LO[32] = {6.420638243e-09f, 2.294664903e-09f, 2.542919653e-09f, -3.316028840e-10f, 5.173299289e-12f, -1.848551645e-09f, -5.826552019e-10f, -3.431038786e-10f, -1.029942243e-10f, 4.320196978e-11f, 6.802745173e-11f, 1.531042237e-10f, 5.173301024e-13f, 4.797548470e-11f, -1.048316434e-10f, 1.053879969e-10f, -5.686555046e-11f, -1.896286773e-11f, 6.802744999e-12f, 2.695195456e-11f, -1.158979943e-11f, -6.843983713e-12f, 1.279990003e-11f, 1.807650600e-12f, 5.954976963e-12f, -3.351478166e-12f, 6.802745216e-13f, -1.670379113e-12f, 1.751403167e-12f, -6.843983930e-13f, -5.389994549e-13f, 9.083608431e-13f};
__constant__ float LOG_GAMMA[6] = {-3.174869716e-02f, -1.574835740e-02f, -7.843177766e-03f, -3.913899418e-03f, -1.955034910e-03f, -9.770396864e-04f};

typedef __bf16 bf16v2 __attribute__((ext_vector_type(2)));
__device__ __forceinline__ unsigned pack2(float a, float b) {
  bf16v2 v;
  v[0] = (__bf16)a;
  v[1] = (__bf16)b;
  return __builtin_bit_cast(unsigned, v);
}
__device__ __forceinline__ bf16_t f2bf(float f) { return (bf16_t)(pack2(f, 0.f) & 0xffffu); }
__device__ __forceinline__ float bf2f(bf16_t h) { return __uint_as_float(((unsigned)h) << 16); }
__device__ __forceinline__ f32x4 mfma16(bf16x8 a, bf16x8 b, f32x4 c) { return __builtin_amdgcn_mfma_f32_16x16x32_bf16(a, b, c, 0, 0, 0); }
__device__ __forceinline__ float fexp2(float x) { return __builtin_amdgcn_exp2f(x); }
__device__ __forceinline__ float flog2(float x) { return __builtin_amdgcn_logf(x); }
__device__ __forceinline__ float siluf(float x) { return x * __builtin_amdgcn_rcpf(1.f + __expf(-x)); }

__device__ __forceinline__ int OTID() { int t = __builtin_amdgcn_workitem_id_x(); asm volatile("" : "+v"(t)); return t; }
__device__ __forceinline__ int UWID(int tid) { return __builtin_amdgcn_readfirstlane(tid >> 6); }

union U4B8 { u32x4 u; bf16x8 v; };
union U2x2B8 { u32x2 u[2]; bf16x8 v; };

struct GTile { const bf16_t* A; const bf16_t* Bt; int lda, ldb, row0, rlo, rhi, col0; };
__device__ __forceinline__ void gemm_issue_tile(const GTile& g, int kt, unsigned char* buf, int wid, int lane) {
  const int lr = lane >> 3, lp = lane & 7;
#pragma unroll
  for (int i = 0; i < 4; ++i) {
    const int q = wid * 4 + i;
    const int r = q * 8 + lr;
    const int c = lp ^ ((r >> 1) & 7);
    int ra = g.row0 + r;
    ra = ra < g.rlo ? g.rlo : (ra > g.rhi ? g.rhi : ra);
    const int lo = __builtin_amdgcn_readfirstlane(q * 1024);
    __builtin_amdgcn_global_load_lds((const unsigned*)(g.A + (size_t)ra * g.lda + c * 8 + kt * 64), (unsigned*)(buf + lo), 16, 0, 0);
    __builtin_amdgcn_global_load_lds((const unsigned*)(g.Bt + (size_t)(g.col0 + r) * g.ldb + c * 8 + kt * 64), (unsigned*)(buf + 16384 + lo), 16, 0, 0);
  }
}
template <bool SWAP>
__device__ __forceinline__ void gemm_mainloop(const GTile& g, const GTile& gn, bool has_next, bool first, int K, unsigned char* base, f32x4 (&acc)[4][4]) {
  const int tid = OTID(), lane = tid & 63, wid = UWID(tid), wr = wid >> 1, wc = wid & 1, fr = lane & 15, fq = lane >> 4;
  const int lr = lane >> 3, lp = lane & 7;
  const bf16_t* ap[4];
  const bf16_t* bp[4];
  int loff[4];
#pragma unroll
  for (int i = 0; i < 4; ++i) {
    const int q = wid * 4 + i;
    const int r = q * 8 + lr;
    const int c = lp ^ ((r >> 1) & 7);
    int ra = g.row0 + r;
    ra = ra < g.rlo ? g.rlo : (ra > g.rhi ? g.rhi : ra);
    ap[i] = g.A + (size_t)ra * g.lda + c * 8;
    bp[i] = g.Bt + (size_t)(g.col0 + r) * g.ldb + c * 8;
    loff[i] = __builtin_amdgcn_readfirstlane(q * 1024);
  }
#pragma unroll
  for (int m = 0; m < 4; ++m)
#pragma unroll
    for (int n = 0; n < 4; ++n) acc[m][n] = (f32x4){0.f, 0.f, 0.f, 0.f};
  int aoff[4], boff[4];
#pragma unroll
  for (int m = 0; m < 4; ++m) { const int R = wr * 64 + m * 16 + fr; aoff[m] = R * 128; }
#pragma unroll
  for (int n = 0; n < 4; ++n) { const int R = wc * 64 + n * 16 + fr; boff[n] = 16384 + R * 128; }
  const int swz = (fr >> 1) & 7;
  const int nk = K >> 6;
#define GEMM_ISSUE(KT, BUFOFF) \
  _Pragma("unroll") for (int i = 0; i < 4; ++i) { \
    __builtin_amdgcn_global_load_lds((const unsigned*)(ap[i] + (KT) * 64), (unsigned*)(base + (BUFOFF) + loff[i]), 16, 0, 0); \
    __builtin_amdgcn_global_load_lds((const unsigned*)(bp[i] + (KT) * 64), (unsigned*)(base + (BUFOFF) + 16384 + loff[i]), 16, 0, 0); }
#define DSR(dst, addr, off) asm volatile("ds_read_b128 %0, %1 offset:%2" : "=v"(dst) : "v"(addr), "n"(off))
#define GEMM_COMPUTE(BUFOFF) \
  { bf16x8 af0[4], bf0[4], af1[4], bf1[4]; \
    DSR(af0[0], adrA0, (BUFOFF)); DSR(af0[1], adrA0, (BUFOFF) + 2048); DSR(af0[2], adrA0, (BUFOFF) + 4096); DSR(af0[3], adrA0, (BUFOFF) + 6144); \
    DSR(bf0[0], adrB0, (BUFOFF) + 16384); DSR(bf0[1], adrB0, (BUFOFF) + 18432); DSR(bf0[2], adrB0, (BUFOFF) + 20480); DSR(bf0[3], adrB0, (BUFOFF) + 22528); \
    DSR(af1[0], adrA1, (BUFOFF)); DSR(af1[1], adrA1, (BUFOFF) + 2048); DSR(af1[2], adrA1, (BUFOFF) + 4096); DSR(af1[3], adrA1, (BUFOFF) + 6144); \
    DSR(bf1[0], adrB1, (BUFOFF) + 16384); DSR(bf1[1], adrB1, (BUFOFF) + 18432); DSR(bf1[2], adrB1, (BUFOFF) + 20480); DSR(bf1[3], adrB1, (BUFOFF) + 22528); \
    asm volatile("s_waitcnt lgkmcnt(8)" : "+v"(af0[0]), "+v"(af0[1]), "+v"(af0[2]), "+v"(af0[3]), "+v"(bf0[0]), "+v"(bf0[1]), "+v"(bf0[2]), "+v"(bf0[3])); \
    __builtin_amdgcn_s_setprio(1); \
    _Pragma("unroll") for (int m = 0; m < 4; ++m) \
      _Pragma("unroll") for (int n = 0; n < 4; ++n) acc[m][n] = SWAP ? mfma16(af0[m], bf0[n], acc[m][n]) : mfma16(bf0[n], af0[m], acc[m][n]); \
    __builtin_amdgcn_sched_barrier(0); \
    asm volatile("s_waitcnt lgkmcnt(0)" : "+v"(af1[0]), "+v"(af1[1]), "+v"(af1[2]), "+v"(af1[3]), "+v"(bf1[0]), "+v"(bf1[1]), "+v"(bf1[2]), "+v"(bf1[3])); \
    __builtin_amdgcn_sched_barrier(0); \
    _Pragma("unroll") for (int m = 0; m < 4; ++m) \
      _Pragma("unroll") for (int n = 0; n < 4; ++n) acc[m][n] = SWAP ? mfma16(af1[m], bf1[n], acc[m][n]) : mfma16(bf1[n], af1[m], acc[m][n]); \
    __builtin_amdgcn_s_setprio(0); }
  const unsigned lbase = (unsigned)(size_t)base;
  const unsigned adrA0 = lbase + (wr * 64 + fr) * 128 + ((0 + fq) ^ swz) * 16, adrA1 = lbase + (wr * 64 + fr) * 128 + ((4 + fq) ^ swz) * 16;
  const unsigned adrB0 = lbase + (wc * 64 + fr) * 128 + ((0 + fq) ^ swz) * 16, adrB1 = lbase + (wc * 64 + fr) * 128 + ((4 + fq) ^ swz) * 16;
  if (first) {
    __syncthreads();
    GEMM_ISSUE(0, 0)
  }
  for (int kt = 0; kt < nk; kt += 2) {
    __syncthreads();
    GEMM_ISSUE(kt + 1, 32768)
    GEMM_COMPUTE(0)
    __syncthreads();
    if (kt + 2 < nk) { GEMM_ISSUE(kt + 2, 0) }
    else if (has_next) gemm_issue_tile(gn, 0, base, wid, lane);
    GEMM_COMPUTE(32768)
  }
}

__device__ __forceinline__ bool tile_map(int t, int MT, int NT, int& mt, int& nt) {
  const int MTm = MT & ~63;
  const int nmain = MTm * NT;
  if (t < nmain) {
    const int x = t & 7, u = t >> 3;
    const int g = u / (8 * NT), rem = u - g * (8 * NT);
    nt = rem >> 3;
    mt = ((g << 3) + (rem & 7)) * 8 + x;
  } else {
    const int r = t - nmain;
    mt = MTm + r / NT;
    nt = r % NT;
  }
  return true;
}
__device__ __forceinline__ int tile_count(int MT, int NT) { return MT * NT; }

__device__ __forceinline__ void store_rows_bf16(bf16_t* buf, int ld, int row0, int colbase, const f32x4 (&acc)[4][4], float scale, bool do_silu) {
  const int lane = OTID() & 63, wid = UWID(OTID()), wr = wid >> 1, fr = lane & 15, fq = lane >> 4;
#pragma unroll
  for (int m = 0; m < 4; ++m) {
    const int row = row0 + wr * 64 + m * 16 + fr;
#pragma unroll
    for (int n = 0; n < 4; ++n) {
      f32x4 v = acc[m][n];
      if (do_silu) { v[0] = siluf(v[0]); v[1] = siluf(v[1]); v[2] = siluf(v[2]); v[3] = siluf(v[3]); }
      u32x2 w;
      w.x = pack2(v[0] * scale, v[1] * scale);
      w.y = pack2(v[2] * scale, v[3] * scale);
      *(u32x2*)(buf + (size_t)row * ld + colbase + n * 16 + fq * 4) = w;
    }
  }
}

__device__ __forceinline__ void rotary_inplace(f32x4 (&acc)[4][4], int row0) {
  const int lane = OTID() & 63, wid = UWID(OTID()), wr = wid >> 1, fr = lane & 15, fq = lane >> 4;
#pragma unroll
  for (int m = 0; m < 4; ++m) {
    const float pos = (float)((row0 + wr * 64 + m * 16 + fr) & (SEQ - 1));
#pragma unroll
    for (int n = 0; n < 2; ++n) {
#pragma unroll
      for (int j = 0; j < 4; ++j) {
        const int i = n * 16 + fq * 4 + j;
        const float fh = ROPE_HI[i], fl = ROPE_LO[i];
        const float ph = pos * fh;
        const float pe = __builtin_fmaf(pos, fh, -ph);
        float rev = (ph - floorf(ph)) + (pe + pos * fl);
        const float sn = __builtin_amdgcn_sinf(rev), cs = __builtin_amdgcn_cosf(rev);
        const float t1 = acc[m][n][j], t2 = acc[m][n + 2][j];
        acc[m][n][j] = t1 * cs - t2 * sn;
        acc[m][n + 2][j] = t1 * sn + t2 * cs;
      }
    }
  }
}

__device__ __forceinline__ void proj_phase(KParams& p, int l, unsigned char* lds, int nb, int bid) {
  const bf16_t* Bt = p.wt_in;
  const int lane = OTID() & 63, wid = UWID(OTID()), wr = wid >> 1, wc = wid & 1, fr = lane & 15, fq = lane >> 4;
  const int NT = IN_PAD / 128;
  const int ntiles = tile_count(NTOK / 128, NT);
  for (int t = bid; t < ntiles; t += nb) {
    int mt, nt, mtn = 0, ntn = 0;
    tile_map(t, NTOK / 128, NT, mt, nt);
    const bool has_next = t + nb < ntiles;
    if (has_next) tile_map(t + nb, NTOK / 128, NT, mtn, ntn);
    const int row0 = mt * 128;
    GTile g, gn;
    g.A = p.hn; g.Bt = Bt; g.lda = DM; g.ldb = DM; g.row0 = row0; g.rlo = 0; g.rhi = NTOK - 1; g.col0 = nt * 128;
    gn = g; gn.row0 = mtn * 128; gn.col0 = ntn * 128;
    const bool vt = (nt >= 6 && nt < 9) || (nt >= 18 && nt < 21) || (nt >= 25 && nt < 27);
    f32x4 acc[4][4];
    if (vt) {
      gemm_mainloop<true>(g, gn, has_next, t == bid, DM, lds, acc);
      bf16_t* dst;
      int head, nh;
      if (nt < 9) { dst = p.lvt; head = (nt - 6) * 2 + wc; nh = 10; }
      else if (nt < 21) { dst = p.svt; head = (nt - 18) * 2 + wc; nh = 6; }
      else { dst = p.lvt; head = 6 + (nt - 25) * 2 + wc; nh = 10; }
      const int b = row0 >> 12;
#pragma unroll
      for (int m = 0; m < 4; ++m) {
        const int pos = ((row0 + wr * 64 + m * 16 + fq * 4) & (SEQ - 1));
#pragma unroll
        for (int n = 0; n < 4; ++n) {
          const int e = n * 16 + fr;
          u32x2 w;
          w.x = pack2(acc[m][n][0], acc[m][n][1]);
          w.y = pack2(acc[m][n][2], acc[m][n][3]);
          *(u32x2*)(dst + ((size_t)(b * nh + head) * 64 + e) * SEQ + pos) = w;
        }
      }
    } else {
      gemm_mainloop<false>(g, gn, has_next, t == bid, DM, lds, acc);
      if (nt < 3) { rotary_inplace(acc, row0); store_rows_bf16(p.lq, 640, row0, nt * 128 + wc * 64, acc, 0.125f, false); }
      else if (nt < 6) { rotary_inplace(acc, row0); store_rows_bf16(p.lk, 640, row0, (nt - 3) * 128 + wc * 64, acc, 1.f, false); }
      else if (nt < 12) { store_rows_bf16(p.lg, 640, row0, (nt - 9) * 128 + wc * 64, acc, 1.f, true); }
      else if (nt < 15) { store_rows_bf16(p.sq, 384, row0, (nt - 12) * 128 + wc * 64, acc, 0.125f * LOG2E, false); }
      else if (nt < 18) { store_rows_bf16(p.sk, 384, row0, (nt - 15) * 128 + wc * 64, acc, 1.f, false); }
      else if (nt < 23) { store_rows_bf16(p.lq, 640, row0, 384 + (nt - 21) * 128 + wc * 64, acc, 0.125f, false); }
      else if (nt < 25) { store_rows_bf16(p.lk, 640, row0, 384 + (nt - 23) * 128 + wc * 64, acc, 1.f, false); }
      else if (nt < 29) { store_rows_bf16(p.lg, 640, row0, 384 + (nt - 27) * 128 + wc * 64, acc, 1.f, true); }
      else {
        if (wc == 0) {
#pragma unroll
          for (int m = 0; m < 4; ++m) {
            const int row = row0 + wr * 64 + m * 16 + fr;
            *(f32x4*)(p.glr + (size_t)row * 16 + fq * 4) = acc[m][0];
          }
        }
      }
    }
  }
}

__device__ __forceinline__ void gemm_y_phase(KParams& p, const bf16_t* A, int K, const bf16_t* Bt, unsigned char* lds, int nb, int bid) {
  const int lane = OTID() & 63, wid = UWID(OTID()), wr = wid >> 1, wc = wid & 1, fr = lane & 15, fq = lane >> 4;
  const int NT = DM / 128;
  const int ntiles = tile_count(NTOK / 128, NT);
  for (int t = bid; t < ntiles; t += nb) {
    int mt, nt, mtn = 0, ntn = 0;
    tile_map(t, NTOK / 128, NT, mt, nt);
    const bool has_next = t + nb < ntiles;
    if (has_next) tile_map(t + nb, NTOK / 128, NT, mtn, ntn);
    const int row0 = mt * 128;
    GTile g, gn;
    g.A = A; g.Bt = Bt; g.lda = K; g.ldb = K; g.row0 = row0; g.rlo = 0; g.rhi = NTOK - 1; g.col0 = nt * 128;
    gn = g; gn.row0 = mtn * 128; gn.col0 = ntn * 128;
    f32x4 acc[4][4];
    gemm_mainloop<false>(g, gn, has_next, t == bid, K, lds, acc);
#pragma unroll
    for (int m = 0; m < 4; ++m) {
      const int row = row0 + wr * 64 + m * 16 + fr;
#pragma unroll
      for (int n = 0; n < 4; ++n) {
        u32x2 w;
        w.x = pack2(acc[m][n][0], acc[m][n][1]);
        w.y = pack2(acc[m][n][2], acc[m][n][3]);
        *(u32x2*)(p.y + (size_t)row * DM + nt * 128 + wc * 64 + n * 16 + fq * 4) = w;
      }
    }
  }
}

__device__ __forceinline__ void up_phase(KParams& p, int l, unsigned char* lds, int nb, int bid) {
  unsigned char* sAct = lds + 32768;
  const int lane = OTID() & 63, wid = UWID(OTID()), wr = wid >> 1, wc = wid & 1, fr = lane & 15, fq = lane >> 4;
  const int NT = DFF / 64;
  const int MT = 4 * 33;
  const int ntiles = tile_count(MT, NT);
  const float* cw = p.conv_w + (size_t)l * 3 * DFF;
  const float* cb = p.conv_b + (size_t)l * DFF;
  for (int t = bid; t < ntiles; t += nb) {
    int mt, nt, mtn = 0, ntn = 0;
    tile_map(t, MT, NT, mt, nt);
    const bool has_next = t + nb < ntiles;
    if (has_next) tile_map(t + nb, MT, NT, mtn, ntn);
    const int b = mt / 33, it = mt % 33;
    const int p0 = it * 126;
    const int row0 = b * SEQ + p0 - 2;
    GTile g, gn;
    g.A = p.hn; g.Bt = p.wt_up; g.lda = DM; g.ldb = DM; g.row0 = row0; g.rlo = b * SEQ; g.rhi = b * SEQ + SEQ - 1; g.col0 = nt * 128;
    {
      const int bn = mtn / 33, itn = mtn % 33;
      gn = g; gn.row0 = bn * SEQ + itn * 126 - 2; gn.rlo = bn * SEQ; gn.rhi = bn * SEQ + SEQ - 1; gn.col0 = ntn * 128;
    }
    f32x4 acc[4][4];
    gemm_mainloop<false>(g, gn, has_next, t == bid, DM, lds, acc);
    asm volatile("s_waitcnt lgkmcnt(0)" ::: "memory");
    __builtin_amdgcn_s_barrier();
    asm volatile("" ::: "memory");
#pragma unroll
    for (int m = 0; m < 4; ++m)
#pragma unroll
      for (int n = 0; n < 2; ++n) {
        const int r = wr * 64 + m * 16 + fr;
        const int c16 = wc * 8 + n * 4 + fq;
        *(f32x4*)(sAct + r * 256 + ((c16 ^ (r & 15)) << 4)) = acc[m][n];
      }
    asm volatile("s_waitcnt lgkmcnt(0)" ::: "memory");
    __builtin_amdgcn_s_barrier();
    asm volatile("" ::: "memory");
#pragma unroll
    for (int n = 0; n < 2; ++n) {
      const int c16 = wc * 8 + n * 4 + fq;
      const int fc = nt * 64 + c16 * 4;
      const f32x4 w0 = *(const f32x4*)(cw + fc), w1 = *(const f32x4*)(cw + DFF + fc), w2 = *(const f32x4*)(cw + 2 * DFF + fc);
      const f32x4 bb = *(const f32x4*)(cb + fc);
#pragma unroll
      for (int m = 0; m < 4; ++m) {
        const int r = wr * 64 + m * 16 + fr;
        const int pos = p0 - 2 + r;
        if (r >= 2 && pos < SEQ) {
          const f32x4 a0 = acc[m][n];
          f32x4 a1 = *(const f32x4*)(sAct + (r - 1) * 256 + ((c16 ^ ((r - 1) & 15)) << 4));
          f32x4 a2 = *(const f32x4*)(sAct + (r - 2) * 256 + ((c16 ^ ((r - 2) & 15)) << 4));
          if (pos < 1) a1 = (f32x4){0.f, 0.f, 0.f, 0.f};
          if (pos < 2) a2 = (f32x4){0.f, 0.f, 0.f, 0.f};
          float hv[4];
#pragma unroll
          for (int j = 0; j < 4; ++j) {
            const float xv = w2[j] * a0[j] + w1[j] * a1[j] + w0[j] * a2[j] + bb[j];
            const float u = 0.7978845608028654f * (xv + 0.044715f * xv * xv * xv);
            const float gl = xv * __builtin_amdgcn_rcpf(1.f + fexp2(-2.f * LOG2E * u));
            hv[j] = gl * acc[m][n + 2][j];
          }
          u32x2 w;
          w.x = pack2(hv[0], hv[1]);
          w.y = pack2(hv[2], hv[3]);
          *(u32x2*)(p.hbuf + (size_t)(b * SEQ + pos) * DFF + fc) = w;
        }
      }
    }
  }
}

__device__ __forceinline__ float wave_sum(float v) {
#pragma unroll
  for (int o = 32; o > 0; o >>= 1) v += __shfl_xor(v, o);
  return v;
}
__device__ __forceinline__ f32x4 ld_mod4(const float* ptr) {
  return ((*(const f32x4*)ptr + *(const f32x4*)(ptr + MOD_PLANE)) + *(const f32x4*)(ptr + 2 * MOD_PLANE)) + *(const f32x4*)(ptr + 3 * MOD_PLANE);
}
__device__ __forceinline__ void rowpass_phase(const float* xsrc, const bf16_t* y, const float* gate, const float* postg, float* xdst,
                              const float* preg, const float* sc, const float* sh, bf16_t* hn, int nb, int bid) {
  const int lane = OTID() & 63, wid = UWID(OTID());
  const int rpw = (NTOK + nb * 4 - 1) / (nb * 4);
  const int rbeg = (bid * 4 + wid) * rpw;
  if (rbeg >= NTOK) return;
  const int rend = rbeg + rpw < NTOK ? rbeg + rpw : NTOK;
  const int b = rbeg >> 12;
  f32x4 vg[4], vpg[4], vpre[4], vsc[4], vsh[4];
#pragma unroll
  for (int i = 0; i < 4; ++i) {
    const int col = i * 256 + lane * 4;
    if (y) { vg[i] = ld_mod4(gate + b * 6144 + col); vpg[i] = *(const f32x4*)(postg + col); }
    if (hn) { vpre[i] = *(const f32x4*)(preg + col); vsc[i] = ld_mod4(sc + b * 6144 + col) + 1.f; vsh[i] = ld_mod4(sh + b * 6144 + col); }
  }
  for (int row0 = rbeg; row0 < rend; row0 += 2) {
    f32x4 xv[2][4];
    u32x2 yr[2][4];
#pragma unroll
    for (int rr = 0; rr < 2; ++rr) {
      const int row = row0 + rr;
      if (row < rend) {
#pragma unroll
        for (int i = 0; i < 4; ++i) xv[rr][i] = __builtin_nontemporal_load((const f32x4*)(xsrc + (size_t)row * DM + i * 256 + lane * 4));
        if (y) {
#pragma unroll
          for (int i = 0; i < 4; ++i) yr[rr][i] = __builtin_nontemporal_load((const u32x2*)(y + (size_t)row * DM + i * 256 + lane * 4));
        }
      }
    }
#pragma unroll
    for (int rr = 0; rr < 2; ++rr) {
      const int row = row0 + rr;
      if (row < rend) {
        if (y) {
          f32x4 yv[4];
          float ss = 0.f;
#pragma unroll
          for (int i = 0; i < 4; ++i) {
            yv[i][0] = __uint_as_float(yr[rr][i].x << 16);
            yv[i][1] = __uint_as_float(yr[rr][i].x & 0xffff0000u);
            yv[i][2] = __uint_as_float(yr[rr][i].y << 16);
            yv[i][3] = __uint_as_float(yr[rr][i].y & 0xffff0000u);
            ss += yv[i][0] * yv[i][0] + yv[i][1] * yv[i][1] + yv[i][2] * yv[i][2] + yv[i][3] * yv[i][3];
          }
          ss = wave_sum(ss);
          const float r = rsqrtf(ss * (1.f / DM) + EPSF);
#pragma unroll
          for (int i = 0; i < 4; ++i) {
            xv[rr][i] = xv[rr][i] + vg[i] * (yv[i] * r) * vpg[i];
            __builtin_nontemporal_store(xv[rr][i], (f32x4*)(xdst + (size_t)row * DM + i * 256 + lane * 4));
          }
        }
        if (hn) {
          float ss = 0.f;
#pragma unroll
          for (int i = 0; i < 4; ++i) ss += xv[rr][i][0] * xv[rr][i][0] + xv[rr][i][1] * xv[rr][i][1] + xv[rr][i][2] * xv[rr][i][2] + xv[rr][i][3] * xv[rr][i][3];
          ss = wave_sum(ss);
          const float r = rsqrtf(ss * (1.f / DM) + EPSF);
#pragma unroll
          for (int i = 0; i < 4; ++i) {
            f32x4 h = (xv[rr][i] * r) * vpre[i] * vsc[i] + vsh[i];
            u32x2 w;
            w.x = pack2(h[0], h[1]);
            w.y = pack2(h[2], h[3]);
            *(u32x2*)(hn + (size_t)row * DM + i * 256 + lane * 4) = w;
          }
        }
      }
    }
  }
}

struct CvtDesc { const float* src; bf16_t* dst; int N, K, k0, ndst0, nsA, nsB; };
__device__ __forceinline__ CvtDesc cvt_decode(KParams& p, int l, int it) {
  const int n_in = 16 * 60, n_out = 16 * 16, n_up = 16 * 88;
  CvtDesc d;
  int i = it;
  if (i < n_in) {
    const int kt = i % 16, ntile = i / 16, ns = ntile * 64;
    d.src = p.w_in + (size_t)l * DM * IN_COLS; d.dst = p.wt_in; d.N = IN_COLS; d.K = DM; d.k0 = kt * 64; d.ndst0 = ns;
    d.nsA = ns < IN_COLS ? ns : -1; d.nsB = ns + 32 < IN_COLS ? ns + 32 : -1;
    return d;
  }
  i -= n_in;
  if (i < n_out) {
    const int kt = i % 16, ntile = i / 16;
    d.src = p.w_out + (size_t)l * DM * DM; d.dst = p.wt_out; d.N = DM; d.K = DM; d.k0 = kt * 64; d.ndst0 = ntile * 64; d.nsA = ntile * 64; d.nsB = ntile * 64 + 32;
    return d;
  }
  i -= n_out;
  if (i < n_up) {
    const int kt = i % 16, q = i / 16;
    const int j = q >> 1, wcv = q & 1;
    d.src = p.w_up + (size_t)l * DM * 2 * DFF; d.dst = p.wt_up; d.N = 2 * DFF; d.K = DM; d.k0 = kt * 64; d.ndst0 = q * 64;
    d.nsA = j * 64 + wcv * 32; d.nsB = DFF + j * 64 + wcv * 32;
    return d;
  }
  i -= n_up;
  {
    const int kt = i % 44, ntile = i / 44;
    d.src = p.w_down + (size_t)l * DFF * DM; d.dst = p.wt_down; d.N = DM; d.K = DFF; d.k0 = kt * 64; d.ndst0 = ntile * 64; d.nsA = ntile * 64; d.nsB = ntile * 64 + 32;
    return d;
  }
}
__device__ __forceinline__ void cvt_load(const CvtDesc& d, int tid, f32x4 (&v)[4]) {
  const int c4 = (tid & 15) * 4, r = tid >> 4;
  const int ns = c4 < 32 ? d.nsA : d.nsB;
  const int sc = ns + (c4 & 31);
  const bool ok = ns >= 0 && sc < d.N;
#pragma unroll
  for (int ps = 0; ps < 4; ++ps) {
    v[ps] = (f32x4){0.f, 0.f, 0.f, 0.f};
    if (ok) v[ps] = __builtin_nontemporal_load((const f32x4*)(d.src + (size_t)(d.k0 + r + 16 * ps) * d.N + sc));
  }
}

__device__ __forceinline__ void convert_weights_phase(KParams& p, int l, unsigned char* lds, int stride, int first, int lo, int hi) {
  float* tiles = (float*)lds;
  const int total = hi;
  const int tid = OTID();
  const int nb = stride, bid = lo + first;
  if (first < 0 || bid >= total) return;
  CvtDesc cur = cvt_decode(p, l, bid);
  f32x4 v[4];
  cvt_load(cur, tid, v);
  int par = 0;
  __syncthreads();
  for (int it = bid; it < total; it += nb) {
    float* tile = tiles + par * (64 * 65);
    {
      const int c4 = (tid & 15) * 4, r = tid >> 4;
#pragma unroll
      for (int ps = 0; ps < 4; ++ps) {
        const int k = r + 16 * ps;
        tile[k * 65 + c4 + 0] = v[ps][0];
        tile[k * 65 + c4 + 1] = v[ps][1];
        tile[k * 65 + c4 + 2] = v[ps][2];
        tile[k * 65 + c4 + 3] = v[ps][3];
      }
    }
    __syncthreads();
    const CvtDesc me = cur;
    if (it + nb < total) { cur = cvt_decode(p, l, it + nb); cvt_load(cur, tid, v); }
    {
      const int n = tid >> 2, kc = (tid & 3) * 16;
      unsigned w[8];
#pragma unroll
      for (int i = 0; i < 8; ++i) w[i] = pack2(tile[(kc + 2 * i) * 65 + n], tile[(kc + 2 * i + 1) * 65 + n]);
      u32x4* dd = (u32x4*)(me.dst + (size_t)(me.ndst0 + n) * me.K + me.k0 + kc);
      dd[0] = (u32x4){w[0], w[1], w[2], w[3]};
      dd[1] = (u32x4){w[4], w[5], w[6], w[7]};
    }
    par ^= 1;
  }
  __syncthreads();
}

__device__ __forceinline__ void mod_phase(KParams& p, unsigned char* lds, int nb, int bid) {
  float* sc_ = (float*)lds;
  float* red = sc_ + 4096;
  const int tid = OTID(), lane = tid & 63, wid = UWID(tid);
  for (int it = bid; it < 192; it += nb) {
    const int l = it / 96, rem = it % 96, cc = (rem >> 2) * 256, kq = rem & 3;
    __syncthreads();
    {
      f32x4 cv[4];
#pragma unroll
      for (int j = 0; j < 4; ++j) cv[j] = *(const f32x4*)(p.c + tid * 16 + j * 4);
#pragma unroll
      for (int j = 0; j < 4; ++j) {
        f32x4 r;
        r[0] = siluf(cv[j][0]); r[1] = siluf(cv[j][1]); r[2] = siluf(cv[j][2]); r[3] = siluf(cv[j][3]);
        *(f32x4*)(sc_ + tid * 16 + j * 4) = r;
      }
    }
    __syncthreads();
    const float* w = p.ada_w + (size_t)l * DM * 6144 + cc + lane * 4;
    f32x4 a0 = (f32x4){0.f, 0.f, 0.f, 0.f}, a1 = a0, a2 = a0, a3 = a0;
    const int kb = kq * 256 + wid * 64;
#pragma unroll 32
    for (int k = kb; k < kb + 64; ++k) {
      const f32x4 wv = __builtin_nontemporal_load((const f32x4*)(w + (size_t)k * 6144));
      a0 += wv * sc_[k];
      a1 += wv * sc_[1024 + k];
      a2 += wv * sc_[2048 + k];
      a3 += wv * sc_[3072 + k];
    }
    *(f32x4*)(red + (wid * 4 + 0) * 256 + lane * 4) = a0;
    *(f32x4*)(red + (wid * 4 + 1) * 256 + lane * 4) = a1;
    *(f32x4*)(red + (wid * 4 + 2) * 256 + lane * 4) = a2;
    *(f32x4*)(red + (wid * 4 + 3) * 256 + lane * 4) = a3;
    __syncthreads();
    {
      const int b = wid;
      f32x4 sv = (*(const f32x4*)(red + (0 * 4 + b) * 256 + lane * 4) + *(const f32x4*)(red + (1 * 4 + b) * 256 + lane * 4)) +
                 (*(const f32x4*)(red + (2 * 4 + b) * 256 + lane * 4) + *(const f32x4*)(red + (3 * 4 + b) * 256 + lane * 4));
      if (kq == 0) sv += *(const f32x4*)(p.ada_b + (size_t)l * 6144 + cc + lane * 4);
      *(f32x4*)(p.mod + (size_t)kq * MOD_PLANE + (size_t)(l * 4 + b) * 6144 + cc + lane * 4) = sv;
    }
  }
}

__device__ __forceinline__ void sb_item(KParams& p, int b, int h, int qt, unsigned char* lds) {
  bf16_t* sK = (bf16_t*)lds;
  bf16_t* sV = sK + 64 * LSTR;
  volatile int* sFlag = (volatile int*)(sV + 64 * LSTR);
  const int tid = OTID(), lane = tid & 63, wid = UWID(tid), fr = lane & 15, fq = lane >> 4;
  const int sr = tid >> 3, sc8 = (tid & 7) * 8;
  const size_t tokq = (size_t)b * SEQ + qt * 64 + wid * 16 + fr;
  bf16x8 qf[2];
#pragma unroll
  for (int ks = 0; ks < 2; ++ks) qf[ks] = *(const bf16x8*)(p.sq + tokq * 384 + h * 64 + ks * 32 + fq * 8);
  f32x4 o[4];
#pragma unroll
  for (int n = 0; n < 4; ++n) o[n] = (f32x4){0.f, 0.f, 0.f, 0.f};
  float carry = 0.f;
  const int tq = qt * 64 + wid * 16 + fr;
  const bf16_t* kbase = p.sk + ((size_t)b * SEQ) * 384 + h * 64 + sc8;
  const bf16_t* vbase = p.svt + ((size_t)(b * 6 + h) * 64) * SEQ + sc8;
  u32x4 kreg[2], vreg[2];
#pragma unroll
  for (int i = 0; i < 2; ++i) {
    kreg[i] = *(const u32x4*)(kbase + (size_t)(qt * 64 + sr + 32 * i) * 384);
    vreg[i] = *(const u32x4*)(vbase + (size_t)(sr + 32 * i) * SEQ + qt * 64);
  }
  __syncthreads();
  for (int kt = qt; kt >= 0; --kt) {
#pragma unroll
    for (int i = 0; i < 2; ++i) {
      *(u32x4*)(sK + (sr + 32 * i) * LSTR + sc8) = kreg[i];
      *(u32x4*)(sV + (sr + 32 * i) * LSTR + sc8) = vreg[i];
    }
    __syncthreads();
    if (kt > 0) {
#pragma unroll
      for (int i = 0; i < 2; ++i) {
        kreg[i] = *(const u32x4*)(kbase + (size_t)((kt - 1) * 64 + sr + 32 * i) * 384);
        vreg[i] = *(const u32x4*)(vbase + (size_t)(sr + 32 * i) * SEQ + (kt - 1) * 64);
      }
    }
    f32x4 z[4];
#pragma unroll
    for (int m = 0; m < 4; ++m) {
      z[m] = (f32x4){0.f, 0.f, 0.f, 0.f};
#pragma unroll
      for (int ks = 0; ks < 2; ++ks) {
        const bf16x8 kf = *(const bf16x8*)(sK + (m * 16 + fr) * LSTR + ks * 32 + fq * 8);
        z[m] = mfma16(kf, qf[ks], z[m]);
      }
    }
    float lk[4][4], lb[4][4];
    const bool diag = (kt == qt);
#pragma unroll
    for (int m = 0; m < 4; ++m)
#pragma unroll
      for (int j = 0; j < 4; ++j) {
        const float zz = z[m][j];
        const float sp = fmaxf(zz, 0.f) + flog2(1.f + fexp2(-fabsf(zz)));
        const int s = kt * 64 + m * 16 + fq * 4 + j;
        const bool valid = (!diag) || (s < tq);
        lk[m][j] = valid ? -sp : 0.f;
        lb[m][j] = valid ? (zz - sp) : -1e30f;
      }
    float tot[4], ex[4];
#pragma unroll
    for (int m = 0; m < 4; ++m) {
      const float s4 = (lk[m][0] + lk[m][1]) + (lk[m][2] + lk[m][3]);
      const float bb = __shfl_xor(s4, 16);
      const float cc = s4 + bb;
      const float dd = __shfl_xor(cc, 32);
      tot[m] = cc + dd;
      ex[m] = ((fq & 1) ? 0.f : bb) + ((fq & 2) ? 0.f : dd);
    }
    float a[4][4];
    float base = carry;
#pragma unroll
    for (int m = 3; m >= 0; --m) {
      float run = base + ex[m];
#pragma unroll
      for (int j = 3; j >= 0; --j) {
        a[m][j] = fexp2(lb[m][j] + run);
        run += lk[m][j];
      }
      base += tot[m];
    }
    carry = base;
#pragma unroll
    for (int u = 0; u < 2; ++u) {
      U4B8 pa;
      pa.u.x = pack2(a[2 * u][0], a[2 * u][1]);
      pa.u.y = pack2(a[2 * u][2], a[2 * u][3]);
      pa.u.z = pack2(a[2 * u + 1][0], a[2 * u + 1][1]);
      pa.u.w = pack2(a[2 * u + 1][2], a[2 * u + 1][3]);
#pragma unroll
      for (int n = 0; n < 4; ++n) {
        U2x2B8 vf;
        vf.u[0] = *(const u32x2*)(sV + (n * 16 + fr) * LSTR + u * 32 + fq * 4);
        vf.u[1] = *(const u32x2*)(sV + (n * 16 + fr) * LSTR + u * 32 + 16 + fq * 4);
        o[n] = mfma16(pa.v, vf.v, o[n]);
      }
    }
    {
      const int wdone = __all(carry < -180.f) ? 1 : 0;
      if (lane == 0) sFlag[wid] = wdone;
      __syncthreads();
      if (sFlag[0] & sFlag[1] & sFlag[2] & sFlag[3]) break;
    }
  }
  bf16_t* ob = p.hn + ((size_t)b * SEQ + qt * 64 + wid * 16) * DM + 384 + h * 64;
#pragma unroll
  for (int n = 0; n < 4; ++n)
#pragma unroll
    for (int j = 0; j < 4; ++j) ob[(size_t)(fq * 4 + j) * DM + n * 16 + fr] = f2bf(o[n][j]);
}

__device__ __forceinline__ void lin_prep(KParams& p, int l, int b, int g, int ic, float (&bc)[16], float& blast, float* sGlr, float* sTot) {
  const int tid = OTID(), lane = tid & 63, wid = UWID(tid);
  if (g < 6) {
    const float lg = LOG_GAMMA[g];
#pragma unroll
    for (int r = 0; r < 16; ++r) bc[r] = (float)(16 * wid + r + 1) * lg;
    blast = 64.f * lg;
  } else {
    const size_t T0 = (size_t)b * SEQ + ic * 64;
    *(f32x4*)(sGlr + tid * 4) = *(const f32x4*)(p.glr + T0 * 16 + tid * 4);
    const int c = (g - 6) * 64 + lane;
    float w2r[16];
#pragma unroll
    for (int rr = 0; rr < 16; ++rr) w2r[rr] = p.gla_w2[((size_t)l * 16 + rr) * 256 + c];
    const float gb = p.gla_b[(size_t)l * 256 + c];
    __syncthreads();
    float run = 0.f;
#pragma unroll
    for (int r = 0; r < 16; ++r) {
      const int t = 16 * wid + r;
      float xv = gb;
#pragma unroll
      for (int rr = 0; rr < 16; ++rr) xv += sGlr[t * 16 + rr] * w2r[rr];
      const float ls = -(fmaxf(-xv, 0.f) + __logf(1.f + __expf(-fabsf(xv))));
      run += ls * (1.f / 16.f);
      bc[r] = run;
    }
    sTot[wid * 64 + lane] = run;
    __syncthreads();
    float off = 0.f, tt = 0.f;
#pragma unroll
    for (int w = 0; w < 4; ++w) {
      const float v = sTot[w * 64 + lane];
      tt += v;
      if (w < wid) off += v;
    }
#pragma unroll
    for (int r = 0; r < 16; ++r) bc[r] += off;
    blast = tt;
  }
}

__device__ __forceinline__ void lin_kv_item(KParams& p, int l, int b, int g, int ic, unsigned char* lds) {
  bf16_t* sKT = (bf16_t*)lds;
  bf16_t* sV = sKT + 64 * LSTR;
  float* sGlr = (float*)(sV + 64 * LSTR);
  float* sTot = sGlr + 1024;
  const int tid = OTID(), lane = tid & 63, wid = UWID(tid), fr = lane & 15, fq = lane >> 4;
  const int bg = b * 10 + g;
  const size_t T0 = (size_t)b * SEQ + ic * 64;
  __syncthreads();
  bf16_t kraw[16];
  u32x4 vreg[2];
  {
#pragma unroll
    for (int r = 0; r < 16; ++r) kraw[r] = p.lk[(T0 + 16 * wid + r) * 640 + g * 64 + lane];
    const int sr = tid >> 3, sc8 = (tid & 7) * 8;
#pragma unroll
    for (int i = 0; i < 2; ++i) vreg[i] = *(const u32x4*)(p.lvt + ((size_t)bg * 64 + sr + 32 * i) * SEQ + ic * 64 + sc8);
  }
  float bc[16], blast;
  lin_prep(p, l, b, g, ic, bc, blast, sGlr, sTot);
  {
    unsigned w[8];
#pragma unroll
    for (int r = 0; r < 16; r += 2) {
      const float k0 = bf2f(kraw[r]);
      const float k1 = bf2f(kraw[r + 1]);
      w[r >> 1] = pack2(k0 * __expf(blast - bc[r]), k1 * __expf(blast - bc[r + 1]));
    }
    u32x4* d = (u32x4*)(sKT + lane * LSTR + 16 * wid);
    d[0] = (u32x4){w[0], w[1], w[2], w[3]};
    d[1] = (u32x4){w[4], w[5], w[6], w[7]};
  }
  {
    const int sr = tid >> 3, sc8 = (tid & 7) * 8;
#pragma unroll
    for (int i = 0; i < 2; ++i) *(u32x4*)(sV + (sr + 32 * i) * LSTR + sc8) = vreg[i];
  }
  __syncthreads();
  float* kvo = p.kvt + ((size_t)bg * 64 + ic) * 4096;
#pragma unroll
  for (int ne = 0; ne < 4; ++ne) {
    f32x4 acc = (f32x4){0.f, 0.f, 0.f, 0.f};
#pragma unroll
    for (int ks = 0; ks < 2; ++ks) {
      const bf16x8 af = *(const bf16x8*)(sKT + (wid * 16 + fr) * LSTR + ks * 32 + fq * 8);
      const bf16x8 bf = *(const bf16x8*)(sV + (ne * 16 + fr) * LSTR + ks * 32 + fq * 8);
      acc = mfma16(af, bf, acc);
    }
    __builtin_nontemporal_store(acc, (f32x4*)(kvo + (ne * 16 + fr) * 64 + wid * 16 + fq * 4));
  }
  if (wid == 0) p.bl[((size_t)bg * 64 + ic) * 64 + lane] = blast;
}

__device__ __forceinline__ void lin_scan_phase(KParams& p, int nb, int bid) {
  const int tid = OTID();
  const int total = 40 * 4096;
  const int per = (total + nb - 1) / nb;
  const int lo = bid * per, hi = lo + per < total ? lo + per : total;
  for (int base = lo; base < hi; base += 512) {
    const int e0 = base + tid, e1 = base + 256 + tid;
    const bool a0 = e0 < hi, a1 = e1 < hi;
    const int ee0 = a0 ? e0 : lo, ee1 = a1 ? e1 : lo;
    const int bg0 = ee0 >> 12, bg1 = ee1 >> 12;
    const int i0x = ee0 & 4095, i1x = ee1 & 4095;
    const float* kv0 = p.kvt + (size_t)bg0 * 64 * 4096 + i0x;
    const float* kv1 = p.kvt + (size_t)bg1 * 64 * 4096 + i1x;
    const float* bl0 = p.bl + (size_t)bg0 * 64 * 64 + (i0x & 63);
    const float* bl1 = p.bl + (size_t)bg1 * 64 * 64 + (i1x & 63);
    bf16_t* so0 = p.st + (size_t)bg0 * 64 * 4096 + i0x;
    bf16_t* so1 = p.st + (size_t)bg1 * 64 * 4096 + i1x;
    float s0 = 0.f, s1 = 0.f;
#pragma nounroll
    for (int c0 = 0; c0 < 64; c0 += 16) {
      float kva[16], da[16], kvb[16], db[16];
#pragma unroll
      for (int i = 0; i < 16; ++i) {
        kva[i] = __builtin_nontemporal_load(kv0 + (size_t)(c0 + i) * 4096);
        da[i] = bl0[(c0 + i) * 64];
      }
      if (a1) {
#pragma unroll
        for (int i = 0; i < 16; ++i) {
          kvb[i] = __builtin_nontemporal_load(kv1 + (size_t)(c0 + i) * 4096);
          db[i] = bl1[(c0 + i) * 64];
        }
      }
      if (a0) {
#pragma unroll
        for (int i = 0; i < 16; ++i) {
          so0[(size_t)(c0 + i) * 4096] = f2bf(s0);
          s0 = __expf(da[i]) * s0 + kva[i];
        }
      }
      if (a1) {
#pragma unroll
        for (int i = 0; i < 16; ++i) {
          so1[(size_t)(c0 + i) * 4096] = f2bf(s1);
          s1 = __expf(db[i]) * s1 + kvb[i];
        }
      }
    }
  }
}

__device__ __forceinline__ void lin_out_item(KParams& p, int l, int b, int g, int ic, unsigned char* lds) {
  bf16_t* sQp = (bf16_t*)lds;
  bf16_t* sQm = sQp + 64 * LSTR;
  bf16_t* sKp = sQm + 64 * LSTR;
  bf16_t* sKm = sKp + 64 * LSTR;
  bf16_t* sV = sKm + 64 * LSTR;
  bf16_t* sS = sV + 64 * LSTR;
  float* sGlr = (float*)(sS + 64 * LSTR);
  float* sTot = sGlr + 1024;
  const int tid = OTID(), lane = tid & 63, wid = UWID(tid), fr = lane & 15, fq = lane >> 4;
  const int bg = b * 10 + g;
  const size_t T0 = (size_t)b * SEQ + ic * 64;
  __syncthreads();
  bf16_t qraw[16], kraw[16];
  u32x4 vreg[2], sreg[2];
  {
#pragma unroll
    for (int r = 0; r < 16; ++r) {
      qraw[r] = p.lq[(T0 + 16 * wid + r) * 640 + g * 64 + lane];
      kraw[r] = p.lk[(T0 + 16 * wid + r) * 640 + g * 64 + lane];
    }
    const int sr = tid >> 3, sc8 = (tid & 7) * 8;
#pragma unroll
    for (int i = 0; i < 2; ++i) {
      vreg[i] = *(const u32x4*)(p.lvt + ((size_t)bg * 64 + sr + 32 * i) * SEQ + ic * 64 + sc8);
      sreg[i] = __builtin_nontemporal_load((const u32x4*)(p.st + ((size_t)bg * 64 + ic) * 4096 + (sr + 32 * i) * 64 + sc8));
    }
  }
  float bc[16], blast;
  lin_prep(p, l, b, g, ic, bc, blast, sGlr, sTot);
#pragma unroll
  for (int r = 0; r < 16; ++r) {
    const int t = 16 * wid + r;
    const float qv = bf2f(qraw[r]);
    const float kv = bf2f(kraw[r]);
    const float ep = __expf(bc[r]), em = __expf(-bc[r]);
    sQp[t * LSTR + lane] = f2bf(qv * ep);
    sQm[t * LSTR + lane] = f2bf(qv * em);
    sKp[t * LSTR + lane] = f2bf(kv * ep);
    sKm[t * LSTR + lane] = f2bf(kv * em);
  }
  {
    const int sr = tid >> 3, sc8 = (tid & 7) * 8;
#pragma unroll
    for (int i = 0; i < 2; ++i) {
      *(u32x4*)(sV + (sr + 32 * i) * LSTR + sc8) = vreg[i];
      *(u32x4*)(sS + (sr + 32 * i) * LSTR + sc8) = sreg[i];
    }
  }
  __syncthreads();
  bf16x8 qpf[2], qmf[2];
#pragma unroll
  for (int ks = 0; ks < 2; ++ks) {
    qpf[ks] = *(const bf16x8*)(sQp + (wid * 16 + fr) * LSTR + ks * 32 + fq * 8);
    qmf[ks] = *(const bf16x8*)(sQm + (wid * 16 + fr) * LSTR + ks * 32 + fq * 8);
  }
  float P[4][4];
#pragma unroll
  for (int ms = 0; ms < 4; ++ms) {
    f32x4 lo = (f32x4){0.f, 0.f, 0.f, 0.f}, up = (f32x4){0.f, 0.f, 0.f, 0.f};
#pragma unroll
    for (int ks = 0; ks < 2; ++ks) {
      const bf16x8 kmf = *(const bf16x8*)(sKm + (ms * 16 + fr) * LSTR + ks * 32 + fq * 8);
      const bf16x8 kpf = *(const bf16x8*)(sKp + (ms * 16 + fr) * LSTR + ks * 32 + fq * 8);
      lo = mfma16(kmf, qpf[ks], lo);
      up = mfma16(kpf, qmf[ks], up);
    }
#pragma unroll
    for (int j = 0; j < 4; ++j) {
      const int s = ms * 16 + fq * 4 + j, t = wid * 16 + fr;
      P[ms][j] = (t >= s) ? lo[j] : up[j];
    }
  }
  f32x4 o[4];
#pragma unroll
  for (int ne = 0; ne < 4; ++ne) o[ne] = (f32x4){0.f, 0.f, 0.f, 0.f};
#pragma unroll
  for (int u = 0; u < 2; ++u) {
    U4B8 pa;
    pa.u.x = pack2(P[2 * u][0], P[2 * u][1]);
    pa.u.y = pack2(P[2 * u][2], P[2 * u][3]);
    pa.u.z = pack2(P[2 * u + 1][0], P[2 * u + 1][1]);
    pa.u.w = pack2(P[2 * u + 1][2], P[2 * u + 1][3]);
#pragma unroll
    for (int ne = 0; ne < 4; ++ne) {
      U2x2B8 vf;
      vf.u[0] = *(const u32x2*)(sV + (ne * 16 + fr) * LSTR + u * 32 + fq * 4);
      vf.u[1] = *(const u32x2*)(sV + (ne * 16 + fr) * LSTR + u * 32 + 16 + fq * 4);
      o[ne] = mfma16(pa.v, vf.v, o[ne]);
    }
  }
#pragma unroll
  for (int ks = 0; ks < 2; ++ks)
#pragma unroll
    for (int ne = 0; ne < 4; ++ne) {
      const bf16x8 sf = *(const bf16x8*)(sS + (ne * 16 + fr) * LSTR + ks * 32 + fq * 8);
      o[ne] = mfma16(qpf[ks], sf, o[ne]);
    }
  const bool isret = (g < 6);
  const float* gam = isret ? (p.ret_norm_g + (size_t)l * 384 + g * 64) : (p.gla_norm_g + (size_t)l * 256 + (g - 6) * 64);
  const int mixcol = isret ? g * 64 : 768 + (g - 6) * 64;
#pragma unroll
  for (int j = 0; j < 4; ++j) {
    float s1 = (o[0][j] + o[1][j]) + (o[2][j] + o[3][j]);
#pragma unroll
    for (int of = 8; of > 0; of >>= 1) s1 += __shfl_xor(s1, of);
    const float mu = isret ? s1 * (1.f / 64.f) : 0.f;
    float s2 = 0.f;
#pragma unroll
    for (int ne = 0; ne < 4; ++ne) { const float dv = o[ne][j] - mu; s2 += dv * dv; }
#pragma unroll
    for (int of = 8; of > 0; of >>= 1) s2 += __shfl_xor(s2, of);
    const float rs = rsqrtf(s2 * (1.f / 64.f) + EPSF);
    const size_t tok = T0 + wid * 16 + fq * 4 + j;
#pragma unroll
    for (int ne = 0; ne < 4; ++ne) {
      const int e = ne * 16 + fr;
      const float gate = bf2f(p.lg[tok * 640 + g * 64 + e]);
      p.hn[tok * DM + mixcol + e] = f2bf((o[ne][j] - mu) * rs * gam[e] * gate);
    }
  }
}

__device__ __forceinline__ void run_phase(KParams& p, int ph, int l, unsigned char* lds, int nb, int bid) {
  const float* modl = p.mod + (size_t)l * 4 * 6144;
  switch (ph) {
    case 0:
      {
        const int CT = 16 * 60 + 16 * 16 + 16 * 88 + 44 * 16;
        const int nmod = nb > 192 ? 192 : 0;
        const int partA = nmod ? 5 * (nb - nmod) : 0;
        if (nmod == 0 || bid < nmod) mod_phase(p, lds, nb, bid);
        else convert_weights_phase(p, 0, lds, nb - nmod, bid - nmod, 0, partA < CT ? partA : CT);
        if (partA < CT) convert_weights_phase(p, 0, lds, nb, bid, partA, CT);
      }
      break;
    case 1:
      rowpass_phase(p.x, nullptr, nullptr, nullptr, nullptr, p.pre_mix_g, p.mod + 1024, p.mod, p.hn, nb, bid);
      break;
    case 2:
      proj_phase(p, l, lds, nb, bid);
      break;
    case 3:
      for (int it = bid; it < 2560; it += nb) lin_kv_item(p, l, it / 640, (it / 64) % 10, it & 63, lds);
      break;
    case 4:
      lin_scan_phase(p, nb, bid);
      break;
    case 5:
      for (int it = bid; it < 1536 + 2560; it += nb) {
        if (it < 1536) {
          sb_item(p, (it % 24) / 6, it % 6, 63 - it / 24, lds);
        } else {
          const int i2 = it - 1536;
          lin_out_item(p, l, i2 / 640, (i2 / 64) % 10, i2 & 63, lds);
        }
      }
      break;
    case 6:
      gemm_y_phase(p, p.hn, DM, p.wt_out, lds, nb, bid);
      break;
    case 7:
      rowpass_phase(l == 0 ? p.x : p.out, p.y, modl + 2048, p.post_mix_g + (size_t)l * DM, p.out, p.pre_ffn_g + (size_t)l * DM,
                    modl + 4096, modl + 3072, p.hn, nb, bid);
      break;
    case 8:
      up_phase(p, l, lds, nb, bid);
      break;
    case 9:
      gemm_y_phase(p, p.hbuf, DFF, p.wt_down, lds, nb, bid);
      break;
    case 10:
      if (l == 0) {
        rowpass_phase(p.out, p.y, modl + 5120, p.post_ffn_g, p.out, p.pre_mix_g + DM, p.mod + 4 * 6144 + 1024, p.mod + 4 * 6144, p.hn, nb, bid);
        convert_weights_phase(p, 1, lds, nb, bid, 0, 16 * 60 + 16 * 16 + 16 * 88 + 44 * 16);
      } else {
        rowpass_phase(p.out, p.y, modl + 5120, p.post_ffn_g + DM, p.out, nullptr, nullptr, nullptr, nullptr, nb, bid);
      }
      break;
  }
}


#define XB_TMO      128
#define XB_XCNT(j)  (256  + 64 * (j))
#define XB_XSUB(j)  (1280 + 64 * (j))
#define XB_XGEN(j)  (2304 + 64 * (j))
#define XB_TOP      3328
#define XB_TOPGEN   3392
#define XCD_BAR_WORDS 3456
#define XB_SPIN_CAP (1u << 20)
#define LAS __attribute__((address_space(3)))
__device__ __forceinline__ unsigned xb_ld(unsigned* p)              { return __hip_atomic_load(p, __ATOMIC_RELAXED, __HIP_MEMORY_SCOPE_AGENT); }
__device__ __forceinline__ unsigned xb_add(unsigned* p, unsigned v) { return __hip_atomic_fetch_add(p, v, __ATOMIC_RELAXED, __HIP_MEMORY_SCOPE_AGENT); }
__device__ __forceinline__ unsigned xb_xcc_id() { return (unsigned)__builtin_amdgcn_s_getreg((3 << 11) | 20) & 0xFu; }
#define XB_SPIN(cond, bar) do { unsigned _sp = 0; while (cond) { __builtin_amdgcn_s_sleep(1); \
    if ((++_sp & 255u) == 0u) { if (xb_ld(&(bar)[XB_TMO])) break; if (_sp > XB_SPIN_CAP) { atomicAdd(&(bar)[XB_TMO], 1u); break; } } } } while (0)
struct XcdBarrier { unsigned* bar; unsigned x; volatile LAS unsigned* st; };
__device__ __forceinline__ XcdBarrier xcd_barrier_post(unsigned* bar, volatile LAS unsigned* st) {
    XcdBarrier b; b.bar = bar; b.x = xb_xcc_id(); b.st = st;
    if (threadIdx.x == 0) (void)xb_add(&bar[XB_XCNT(b.x)], 1u);
    return b;
}
__device__ __forceinline__ void xcd_barrier_complete(unsigned* bar, unsigned x, unsigned& nloc, unsigned& nx) {
    const unsigned G = gridDim.x * gridDim.y * gridDim.z;
    unsigned sum, cnt, mine, sp = 0u;
    for (;;) {
        sum = 0u; cnt = 0u; mine = 0u;
#pragma unroll
        for (unsigned j = 0; j < 16; ++j) { const unsigned c = xb_ld(&bar[XB_XCNT(j)]); sum += c; cnt += (c > 0u) ? 1u : 0u; mine = (j == x) ? c : mine; }
        if (sum == G) break;
        __builtin_amdgcn_s_sleep(1);
        if ((++sp & 255u) == 0u) { if (xb_ld(&bar[XB_TMO])) break; if (sp > XB_SPIN_CAP) { atomicAdd(&bar[XB_TMO], 1u); break; } }
    }
    nloc = mine > 0u ? mine : 1u; nx = cnt > 0u ? cnt : 1u;
}
__device__ __forceinline__ void xcd_barrier(const XcdBarrier& b) {
    asm volatile("s_waitcnt vmcnt(0)" ::: "memory");
    __syncthreads();
    if (threadIdx.x == 0) {
        unsigned* bar = b.bar;
        __builtin_amdgcn_s_waitcnt(0);
        unsigned nloc = b.st[0], nx = b.st[1];
        if (nloc == 0u) { xcd_barrier_complete(bar, b.x, nloc, nx); b.st[0] = nloc; b.st[1] = nx; }
        const unsigned old = xb_add(&bar[XB_XSUB(b.x)], 1u);
        const unsigned gen = old / nloc;
        if (old + 1u == (gen + 1u) * nloc) {
            __builtin_amdgcn_fence(__ATOMIC_RELEASE, "agent");
            asm volatile("s_waitcnt vmcnt(0)" ::: "memory");
            const unsigned og = xb_add(&bar[XB_TOP], 1u);
            const unsigned tg = og / nx;
            if (og + 1u == (tg + 1u) * nx) xb_add(&bar[XB_TOPGEN], 1u);
            else XB_SPIN(xb_ld(&bar[XB_TOPGEN]) == tg, bar);
            __builtin_amdgcn_fence(__ATOMIC_ACQUIRE, "agent");
            xb_add(&bar[XB_XGEN(b.x)], 1u);
            asm volatile("s_waitcnt vmcnt(0)" ::: "memory");
        } else {
            XB_SPIN(xb_ld(&bar[XB_XGEN(b.x)]) == gen, bar);
            __builtin_amdgcn_fence(__ATOMIC_ACQUIRE, "agent");
            asm volatile("s_waitcnt vmcnt(0)" ::: "memory");
        }
    }
    __syncthreads();
}

__global__ void __launch_bounds__(256, 2) mega_kernel(Params p) {
  __shared__ __attribute__((aligned(16))) unsigned char lds[LDS_BYTES + 16];
  cg::grid_group grid = cg::this_grid();
  const int nb = gridDim.x, bid = blockIdx.x;
  volatile LAS unsigned* st = (volatile LAS unsigned*)(lds + LDS_BYTES);
  if (threadIdx.x < 4) st[threadIdx.x] = 0u;
  __syncthreads();
  if (p.x == nullptr) grid.sync();
  XcdBarrier xb = xcd_barrier_post(p.bar, st);
  for (int step = 0; step < 20; ++step) {
    const int l = step >= 11 ? 1 : 0;
    const int ph = step < 2 ? step : (step >= 11 ? step - 9 : step);
    int nb_ = nb, bid_ = bid;
    KParams* kp = (KParams*)__builtin_amdgcn_kernarg_segment_ptr();
    asm volatile("" : "+s"(nb_), "+s"(bid_), "+s"(kp));
    run_phase(*kp, ph, l, lds, nb_, bid_);
    if (step < 19) xcd_barrier(xb);
  }
}

extern "C" void kernel_launch(void* const* d_in, const int* in_sizes, int n_in, void* d_out, int out_size, void* d_ws,
                              size_t ws_size, hipStream_t stream) {
  Params p{};
  p.x = (const float*)d_in[0];
  p.c = (const float*)d_in[1];
  p.ada_w = (const float*)d_in[2];
  p.ada_b = (const float*)d_in[3];
  p.pre_mix_g = (const float*)d_in[4];
  p.post_mix_g = (const float*)d_in[5];
  p.w_in = (const float*)d_in[6];
  p.gla_w2 = (const float*)d_in[7];
  p.gla_b = (const float*)d_in[8];
  p.ret_norm_g = (const float*)d_in[9];
  p.gla_norm_g = (const float*)d_in[10];
  p.w_out = (const float*)d_in[11];
  p.pre_ffn_g = (const float*)d_in[12];
  p.post_ffn_g = (const float*)d_in[13];
  p.w_up = (const float*)d_in[14];
  p.conv_w = (const float*)d_in[15];
  p.conv_b = (const float*)d_in[16];
  p.w_down = (const float*)d_in[17];
  p.out = (float*)d_out;
  unsigned char* ws = (unsigned char*)d_ws;
  size_t off = 0;
  p.wt_in = (bf16_t*)(ws + off); off += (size_t)IN_PAD * DM * 2;
  p.wt_out = (bf16_t*)(ws + off); off += (size_t)DM * DM * 2;
  p.wt_up = (bf16_t*)(ws + off); off += (size_t)2 * DFF * DM * 2;
  p.wt_down = (bf16_t*)(ws + off); off += (size_t)DM * DFF * 2;
  p.mod = (float*)(ws + off); off += (size_t)4 * MOD_PLANE * 4;
  p.hn = (bf16_t*)(ws + off); off += (size_t)NTOK * DM * 2;
  const size_t r1 = off;
  p.lq = (bf16_t*)(ws + off); off += (size_t)NTOK * 640 * 2;
  p.lk = (bf16_t*)(ws + off); off += (size_t)NTOK * 640 * 2;
  p.lvt = (bf16_t*)(ws + off); off += (size_t)NTOK * 640 * 2;
  p.lg = (bf16_t*)(ws + off); off += (size_t)NTOK * 640 * 2;
  p.sq = (bf16_t*)(ws + off); off += (size_t)NTOK * 384 * 2;
  p.sk = (bf16_t*)(ws + off); off += (size_t)NTOK * 384 * 2;
  p.svt = (bf16_t*)(ws + off); off += (size_t)NTOK * 384 * 2;
  p.glr = (float*)(ws + off); off += (size_t)NTOK * 16 * 4;
  p.hbuf = (bf16_t*)(ws + r1);
  const size_t r2 = off;
  p.y = (bf16_t*)(ws + r2);
  p.kvt = (float*)(ws + r2);
  p.st = (bf16_t*)(ws + r2 + (size_t)40 * 64 * 4096 * 4);
  p.bl = (float*)(ws + r2 + (size_t)40 * 64 * 4096 * 4 + (size_t)40 * 64 * 4096 * 2);
  off += (size_t)NTOK * DM * 4;
  p.bar = (unsigned*)(ws + off); off += 16384;
  if (off > ws_size) { fprintf(stderr, "workspace too small: need %zu have %zu\n", off, ws_size); return; }

  static int grid_blocks = 0;
  if (!grid_blocks) {
    int dev = 0, cus = 0, per_cu = 0;
    hipGetDevice(&dev);
    hipDeviceGetAttribute(&cus, hipDeviceAttributeMultiprocessorCount, dev);
    hipOccupancyMaxActiveBlocksPerMultiprocessor(&per_cu, mega_kernel, 256, 0);
    if (per_cu > 2) per_cu = 2;
    if (per_cu < 1) per_cu = 1;
    grid_blocks = cus * per_cu;
  }
  (void)hipMemsetAsync(p.bar, 0, 16384, stream);
  void* args[] = {&p};
  hipError_t e = hipLaunchCooperativeKernel((void*)mega_kernel, dim3(grid_blocks), dim3(256), args, 0, stream);
  if (e != hipSuccess) fprintf(stderr, "cooperative launch failed: %s (grid %d)\n", hipGetErrorString(e), grid_blocks);
}
```

```cpp
#include <hip/hip_runtime.h>
#include <hip/hip_cooperative_groups.h>
#include <cstdio>
#include <cstdint>
namespace cg = cooperative_groups;

#ifndef DUPMASK
#define DUPMASK 0
#endif
#ifndef MODE_MULTI
#define MODE_MULTI 0
#endif

typedef unsigned short bf16_t;
typedef short bf16x8 __attribute__((ext_vector_type(8)));
typedef float f32x4 __attribute__((ext_vector_type(4)));
typedef unsigned u32x4 __attribute__((ext_vector_type(4)));
typedef unsigned u32x2 __attribute__((ext_vector_type(2)));

#define NTOK 16384
#define SEQ 4096
#define DM 1024
#define IN_COLS 3728
#define IN_PAD 3840
#define DFF 2816
#define LSTR 72
#define LDS_BYTES 65536
#define EPSF 1e-6f
#define LOG2E 1.4426950408889634f
#define MOD_PLANE (2 * 4 * 6144)

struct Params {
  const float *x, *c, *ada_w, *ada_b, *pre_mix_g, *post_mix_g, *w_in, *gla_w2, *gla_b, *ret_norm_g, *gla_norm_g,
      *w_out, *pre_ffn_g, *post_ffn_g, *w_up, *conv_w, *conv_b, *w_down;
  float* out;
  bf16_t *wt_in, *wt_out, *wt_up, *wt_down;
  float* mod;
  bf16_t* hn;
  bf16_t *lq, *lk, *lvt, *lg, *sq, *sk, *svt;
  float* glr;
  bf16_t* hbuf;
  bf16_t* y;
  float* kvt;
  bf16_t* st;
  float* bl;
  unsigned* bar;
};
typedef const __attribute__((address_space(4))) Params KParams;

__constant__ float ROPE_HI[32] = {1.591549367e-01f, 1.193493679e-01f, 8.949939907e-02f, 6.711508334e-02f, 5.032921210e-02f, 3.774158657e-02f, 2.830219641e-02f, 2.122365311e-02f, 1.591549441e-02f, 1.193493698e-02f, 8.949940093e-03f, 6.711508147e-03f, 5.032921210e-03f, 3.774158424e-03f, 2.830219688e-03f, 2.122365171e-03f, 1.591549488e-03f, 1.193493721e-03f, 8.949940093e-04f, 6.711508031e-04f, 5.032921326e-04f, 3.774158540e-04f, 2.830219455e-04f, 2.122365258e-04f, 1.591549371e-04f, 1.193493736e-04f, 8.949940093e-05f, 6.711508468e-05f, 5.032921035e-05f, 3.774158540e-05f, 2.830219637e-05f, 2.122365186e-05f};
__constant__ float ROPE_LO[32] = {6.420638243e-09f, 2.294664903e-09f, 2.542919653e-09f, -3.316028840e-10f, 5.173299289e-12f, -1.848551645e-09f, -5.826552019e-10f, -3.431038786e-10f, -1.029942243e-10f, 4.320196978e-11f, 6.802745173e-11f, 1.531042237e-10f, 5.173301024e-13f, 4.797548470e-11f, -1.048316434e-10f, 1.053879969e-10f, -5.686555046e-11f, -1.896286773e-11f, 6.802744999e-12f, 2.695195456e-11f, -1.158979943e-11f, -6.843983713e-12f, 1.279990003e-11f, 1.807650600e-12f, 5.954976963e-12f, -3.351478166e-12f, 6.802745216e-13f, -1.670379113e-12f, 1.751403167e-12f, -6.843983930e-13f, -5.389994549e-13f, 9.083608431e-13f};
__constant__ float LOG_GAMMA[6] = {-3.174869716e-02f, -1.574835740e-02f, -7.843177766e-03f, -3.913899418e-03f, -1.955034910e-03f, -9.770396864e-04f};

typedef __bf16 bf16v2 __attribute__((ext_vector_type(2)));
__device__ __forceinline__ unsigned pack2(float a, float b) {
  bf16v2 v;
  v[0] = (__bf16)a;
  v[1] = (__bf16)b;
  return __builtin_bit_cast(unsigned, v);
}
__device__ __forceinline__ bf16_t f2bf(float f) { return (bf16_t)(pack2(f, 0.f) & 0xffffu); }
__device__ __forceinline__ float bf2f(bf16_t h) { return __uint_as_float(((unsigned)h) << 16); }
__device__ __forceinline__ f32x4 mfma16(bf16x8 a, bf16x8 b, f32x4 c) { return __builtin_amdgcn_mfma_f32_16x16x32_bf16(a, b, c, 0, 0, 0); }
__device__ __forceinline__ float fexp2(float x) { return __builtin_amdgcn_exp2f(x); }
__device__ __forceinline__ float flog2(float x) { return __builtin_amdgcn_logf(x); }
__device__ __forceinline__ float siluf(float x) { return x * __builtin_amdgcn_rcpf(1.f + __expf(-x)); }

__device__ __forceinline__ int OTID() { int t = __builtin_amdgcn_workitem_id_x(); asm volatile("" : "+v"(t)); return t; }
__device__ __forceinline__ int UWID(int tid) { return __builtin_amdgcn_readfirstlane(tid >> 6); }

union U4B8 { u32x4 u; bf16x8 v; };
union U2x2B8 { u32x2 u[2]; bf16x8 v; };

struct GTile { const bf16_t* A; const bf16_t* Bt; int lda, ldb, row0, rlo, rhi, col0; };
__device__ __forceinline__ void gemm_issue_tile(const GTile& g, int kt, unsigned char* buf, int wid, int lane) {
  const int lr = lane >> 3, lp = lane & 7;
#pragma unroll
  for (int i = 0; i < 4; ++i) {
    const int q = wid * 4 + i;
    const int r = q * 8 + lr;
    const int c = lp ^ ((r >> 1) & 7);
    int ra = g.row0 + r;
    ra = ra < g.rlo ? g.rlo : (ra > g.rhi ? g.rhi : ra);
    const int lo = __builtin_amdgcn_readfirstlane(q * 1024);
    __builtin_amdgcn_global_load_lds((const unsigned*)(g.A + (size_t)ra * g.lda + c * 8 + kt * 64), (unsigned*)(buf + lo), 16, 0, 0);
    __builtin_amdgcn_global_load_lds((const unsigned*)(g.Bt + (size_t)(g.col0 + r) * g.ldb + c * 8 + kt * 64), (unsigned*)(buf + 16384 + lo), 16, 0, 0);
  }
}
template <bool SWAP>
__device__ __forceinline__ void gemm_mainloop(const GTile& g, const GTile& gn, bool has_next, bool first, int K, unsigned char* base, f32x4 (&acc)[4][4]) {
  const int tid = OTID(), lane = tid & 63, wid = UWID(tid), wr = wid >> 1, wc = wid & 1, fr = lane & 15, fq = lane >> 4;
  const int lr = lane >> 3, lp = lane & 7;
  const bf16_t* ap[4];
  const bf16_t* bp[4];
  int loff[4];
#pragma unroll
  for (int i = 0; i < 4; ++i) {
    const int q = wid * 4 + i;
    const int r = q * 8 + lr;
    const int c = lp ^ ((r >> 1) & 7);
    int ra = g.row0 + r;
    ra = ra < g.rlo ? g.rlo : (ra > g.rhi ? g.rhi : ra);
    ap[i] = g.A + (size_t)ra * g.lda + c * 8;
    bp[i] = g.Bt + (size_t)(g.col0 + r) * g.ldb + c * 8;
    loff[i] = __builtin_amdgcn_readfirstlane(q * 1024);
  }
#pragma unroll
  for (int m = 0; m < 4; ++m)
#pragma unroll
    for (int n = 0; n < 4; ++n) acc[m][n] = (f32x4){0.f, 0.f, 0.f, 0.f};
  int aoff[4], boff[4];
#pragma unroll
  for (int m = 0; m < 4; ++m) { const int R = wr * 64 + m * 16 + fr; aoff[m] = R * 128; }
#pragma unroll
  for (int n = 0; n < 4; ++n) { const int R = wc * 64 + n * 16 + fr; boff[n] = 16384 + R * 128; }
  const int swz = (fr >> 1) & 7;
  const int nk = K >> 6;
#define GEMM_ISSUE(KT, BUFOFF) \
  _Pragma("unroll") for (int i = 0; i < 4; ++i) { \
    __builtin_amdgcn_global_load_lds((const unsigned*)(ap[i] + (KT) * 64), (unsigned*)(base + (BUFOFF) + loff[i]), 16, 0, 0); \
    __builtin_amdgcn_global_load_lds((const unsigned*)(bp[i] + (KT) * 64), (unsigned*)(base + (BUFOFF) + 16384 + loff[i]), 16, 0, 0); }
#define DSR(dst, addr, off) asm volatile("ds_read_b128 %0, %1 offset:%2" : "=v"(dst) : "v"(addr), "n"(off))
#define GEMM_COMPUTE(BUFOFF) \
  { bf16x8 af0[4], bf0[4], af1[4], bf1[4]; \
    DSR(af0[0], adrA0, (BUFOFF)); DSR(af0[1], adrA0, (BUFOFF) + 2048); DSR(af0[2], adrA0, (BUFOFF) + 4096); DSR(af0[3], adrA0, (BUFOFF) + 6144); \
    DSR(bf0[0], adrB0, (BUFOFF) + 16384); DSR(bf0[1], adrB0, (BUFOFF) + 18432); DSR(bf0[2], adrB0, (BUFOFF) + 20480); DSR(bf0[3], adrB0, (BUFOFF) + 22528); \
    DSR(af1[0], adrA1, (BUFOFF)); DSR(af1[1], adrA1, (BUFOFF) + 2048); DSR(af1[2], adrA1, (BUFOFF) + 4096); DSR(af1[3], adrA1, (BUFOFF) + 6144); \
    DSR(bf1[0], adrB1, (BUFOFF) + 16384); DSR(bf1[1], adrB1, (BUFOFF) + 18432); DSR(bf1[2], adrB1, (BUFOFF) + 20480); DSR(bf1[3], adrB1, (BUFOFF) + 22528); \
    asm volatile("s_waitcnt lgkmcnt(8)" : "+v"(af0[0]), "+v"(af0[1]), "+v"(af0[2]), "+v"(af0[3]), "+v"(bf0[0]), "+v"(bf0[1]), "+v"(bf0[2]), "+v"(bf0[3])); \
    __builtin_amdgcn_s_setprio(1); \
    _Pragma("unroll") for (int m = 0; m < 4; ++m) \
      _Pragma("unroll") for (int n = 0; n < 4; ++n) acc[m][n] = SWAP ? mfma16(af0[m], bf0[n], acc[m][n]) : mfma16(bf0[n], af0[m], acc[m][n]); \
    __builtin_amdgcn_sched_barrier(0); \
    asm volatile("s_waitcnt lgkmcnt(0)" : "+v"(af1[0]), "+v"(af1[1]), "+v"(af1[2]), "+v"(af1[3]), "+v"(bf1[0]), "+v"(bf1[1]), "+v"(bf1[2]), "+v"(bf1[3])); \
    __builtin_amdgcn_sched_barrier(0); \
    _Pragma("unroll") for (int m = 0; m < 4; ++m) \
      _Pragma("unroll") for (int n = 0; n < 4; ++n) acc[m][n] = SWAP ? mfma16(af1[m], bf1[n], acc[m][n]) : mfma16(bf1[n], af1[m], acc[m][n]); \
    __builtin_amdgcn_s_setprio(0); }
  const unsigned lbase = (unsigned)(size_t)base;
  const unsigned adrA0 = lbase + (wr * 64 + fr) * 128 + ((0 + fq) ^ swz) * 16, adrA1 = lbase + (wr * 64 + fr) * 128 + ((4 + fq) ^ swz) * 16;
  const unsigned adrB0 = lbase + (wc * 64 + fr) * 128 + ((0 + fq) ^ swz) * 16, adrB1 = lbase + (wc * 64 + fr) * 128 + ((4 + fq) ^ swz) * 16;
  if (first) {
    __syncthreads();
    GEMM_ISSUE(0, 0)
  }
  for (int kt = 0; kt < nk; kt += 2) {
    __syncthreads();
    GEMM_ISSUE(kt + 1, 32768)
    GEMM_COMPUTE(0)
    __syncthreads();
    if (kt + 2 < nk) { GEMM_ISSUE(kt + 2, 0) }
    else if (has_next) gemm_issue_tile(gn, 0, base, wid, lane);
    GEMM_COMPUTE(32768)
  }
}

__device__ __forceinline__ bool tile_map(int t, int MT, int NT, int& mt, int& nt) {
  const int MTm = MT & ~63;
  const int nmain = MTm * NT;
  if (t < nmain) {
    const int x = t & 7, u = t >> 3;
    const int g = u / (8 * NT), rem = u - g * (8 * NT);
    nt = rem >> 3;
    mt = ((g << 3) + (rem & 7)) * 8 + x;
  } else {
    const int r = t - nmain;
    mt = MTm + r / NT;
    nt = r % NT;
  }
  return true;
}
__device__ __forceinline__ int tile_count(int MT, int NT) { return MT * NT; }

__device__ __forceinline__ void store_rows_bf16(bf16_t* buf, int ld, int row0, int colbase, const f32x4 (&acc)[4][4], float scale, bool do_silu) {
  const int lane = OTID() & 63, wid = UWID(OTID()), wr = wid >> 1, fr = lane & 15, fq = lane >> 4;
#pragma unroll
  for (int m = 0; m < 4; ++m) {
    const int row = row0 + wr * 64 + m * 16 + fr;
#pragma unroll
    for (int n = 0; n < 4; ++n) {
      f32x4 v = acc[m][n];
      if (do_silu) { v[0] = siluf(v[0]); v[1] = siluf(v[1]); v[2] = siluf(v[2]); v[3] = siluf(v[3]); }
      u32x2 w;
      w.x = pack2(v[0] * scale, v[1] * scale);
      w.y = pack2(v[2] * scale, v[3] * scale);
      *(u32x2*)(buf + (size_t)row * ld + colbase + n * 16 + fq * 4) = w;
    }
  }
}

__device__ __forceinline__ void rotary_inplace(f32x4 (&acc)[4][4], int row0) {
  const int lane = OTID() & 63, wid = UWID(OTID()), wr = wid >> 1, fr = lane & 15, fq = lane >> 4;
#pragma unroll
  for (int m = 0; m < 4; ++m) {
    const float pos = (float)((row0 + wr * 64 + m * 16 + fr) & (SEQ - 1));
#pragma unroll
    for (int n = 0; n < 2; ++n) {
#pragma unroll
      for (int j = 0; j < 4; ++j) {
        const int i = n * 16 + fq * 4 + j;
        const float fh = ROPE_HI[i], fl = ROPE_LO[i];
        const float ph = pos * fh;
        const float pe = __builtin_fmaf(pos, fh, -ph);
        float rev = (ph - floorf(ph)) + (pe + pos * fl);
        const float sn = __builtin_amdgcn_sinf(rev), cs = __builtin_amdgcn_cosf(rev);
        const float t1 = acc[m][n][j], t2 = acc[m][n + 2][j];
        acc[m][n][j] = t1 * cs - t2 * sn;
        acc[m][n + 2][j] = t1 * sn + t2 * cs;
      }
    }
  }
}

__device__ __forceinline__ void proj_phase(KParams& p, int l, unsigned char* lds, int nb, int bid) {
  const bf16_t* Bt = p.wt_in;
  const int lane = OTID() & 63, wid = UWID(OTID()), wr = wid >> 1, wc = wid & 1, fr = lane & 15, fq = lane >> 4;
  const int NT = IN_PAD / 128;
  const int ntiles = tile_count(NTOK / 128, NT);
  for (int t = bid; t < ntiles; t += nb) {
    int mt, nt, mtn = 0, ntn = 0;
    tile_map(t, NTOK / 128, NT, mt, nt);
    const bool has_next = t + nb < ntiles;
    if (has_next) tile_map(t + nb, NTOK / 128, NT, mtn, ntn);
    const int row0 = mt * 128;
    GTile g, gn;
    g.A = p.hn; g.Bt = Bt; g.lda = DM; g.ldb = DM; g.row0 = row0; g.rlo = 0; g.rhi = NTOK - 1; g.col0 = nt * 128;
    gn = g; gn.row0 = mtn * 128; gn.col0 = ntn * 128;
    const bool vt = (nt >= 6 && nt < 9) || (nt >= 18 && nt < 21) || (nt >= 25 && nt < 27);
    f32x4 acc[4][4];
    if (vt) {
      gemm_mainloop<true>(g, gn, has_next, t == bid, DM, lds, acc);
      bf16_t* dst;
      int head, nh;
      if (nt < 9) { dst = p.lvt; head = (nt - 6) * 2 + wc; nh = 10; }
      else if (nt < 21) { dst = p.svt; head = (nt - 18) * 2 + wc; nh = 6; }
      else { dst = p.lvt; head = 6 + (nt - 25) * 2 + wc; nh = 10; }
      const int b = row0 >> 12;
#pragma unroll
      for (int m = 0; m < 4; ++m) {
        const int pos = ((row0 + wr * 64 + m * 16 + fq * 4) & (SEQ - 1));
#pragma unroll
        for (int n = 0; n < 4; ++n) {
          const int e = n * 16 + fr;
          u32x2 w;
          w.x = pack2(acc[m][n][0], acc[m][n][1]);
          w.y = pack2(acc[m][n][2], acc[m][n][3]);
          *(u32x2*)(dst + ((size_t)(b * nh + head) * 64 + e) * SEQ + pos) = w;
        }
      }
    } else {
      gemm_mainloop<false>(g, gn, has_next, t == bid, DM, lds, acc);
      if (nt < 3) { rotary_inplace(acc, row0); store_rows_bf16(p.lq, 640, row0, nt * 128 + wc * 64, acc, 0.125f, false); }
      else if (nt < 6) { rotary_inplace(acc, row0); store_rows_bf16(p.lk, 640, row0, (nt - 3) * 128 + wc * 64, acc, 1.f, false); }
      else if (nt < 12) { store_rows_bf16(p.lg, 640, row0, (nt - 9) * 128 + wc * 64, acc, 1.f, true); }
      else if (nt < 15) { store_rows_bf16(p.sq, 384, row0, (nt - 12) * 128 + wc * 64, acc, 0.125f * LOG2E, false); }
      else if (nt < 18) { store_rows_bf16(p.sk, 384, row0, (nt - 15) * 128 + wc * 64, acc, 1.f, false); }
      else if (nt < 23) { store_rows_bf16(p.lq, 640, row0, 384 + (nt - 21) * 128 + wc * 64, acc, 0.125f, false); }
      else if (nt < 25) { store_rows_bf16(p.lk, 640, row0, 384 + (nt - 23) * 128 + wc * 64, acc, 1.f, false); }
      else if (nt < 29) { store_rows_bf16(p.lg, 640, row0, 384 + (nt - 27) * 128 + wc * 64, acc, 1.f, true); }
      else {
        if (wc == 0) {
#pragma unroll
          for (int m = 0; m < 4; ++m) {
            const int row = row0 + wr * 64 + m * 16 + fr;
            *(f32x4*)(p.glr + (size_t)row * 16 + fq * 4) = acc[m][0];
          }
        }
      }
    }
  }
}

__device__ __forceinline__ void gemm_y_phase(KParams& p, const bf16_t* A, int K, const bf16_t* Bt, unsigned char* lds, int nb, int bid) {
  const int lane = OTID() & 63, wid = UWID(OTID()), wr = wid >> 1, wc = wid & 1, fr = lane & 15, fq = lane >> 4;
  const int NT = DM / 128;
  const int ntiles = tile_count(NTOK / 128, NT);
  for (int t = bid; t < ntiles; t += nb) {
    int mt, nt, mtn = 0, ntn = 0;
    tile_map(t, NTOK / 128, NT, mt, nt);
    const bool has_next = t + nb < ntiles;
    if (has_next) tile_map(t + nb, NTOK / 128, NT, mtn, ntn);
    const int row0 = mt * 128;
    GTile g, gn;
    g.A = A; g.Bt = Bt; g.lda = K; g.ldb = K; g.row0 = row0; g.rlo = 0; g.rhi = NTOK - 1; g.col0 = nt * 128;
    gn = g; gn.row0 = mtn * 128; gn.col0 = ntn * 128;
    f32x4 acc[4][4];
    gemm_mainloop<false>(g, gn, has_next, t == bid, K, lds, acc);
#pragma unroll
    for (int m = 0; m < 4; ++m) {
      const int row = row0 + wr * 64 + m * 16 + fr;
#pragma unroll
      for (int n = 0; n < 4; ++n) {
        u32x2 w;
        w.x = pack2(acc[m][n][0], acc[m][n][1]);
        w.y = pack2(acc[m][n][2], acc[m][n][3]);
        *(u32x2*)(p.y + (size_t)row * DM + nt * 128 + wc * 64 + n * 16 + fq * 4) = w;
      }
    }
  }
}

__device__ __forceinline__ void up_phase(KParams& p, int l, unsigned char* lds, int nb, int bid) {
  unsigned char* sAct = lds + 32768;
  const int lane = OTID() & 63, wid = UWID(OTID()), wr = wid >> 1, wc = wid & 1, fr = lane & 15, fq = lane >> 4;
  const int NT = DFF / 64;
  const int MT = 4 * 33;
  const int ntiles = tile_count(MT, NT);
  const float* cw = p.conv_w + (size_t)l * 3 * DFF;
  const float* cb = p.conv_b + (size_t)l * DFF;
  for (int t = bid; t < ntiles; t += nb) {
    int mt, nt, mtn = 0, ntn = 0;
    tile_map(t, MT, NT, mt, nt);
    const bool has_next = t + nb < ntiles;
    if (has_next) tile_map(t + nb, MT, NT, mtn, ntn);
    const int b = mt / 33, it = mt % 33;
    const int p0 = it * 126;
    const int row0 = b * SEQ + p0 - 2;
    GTile g, gn;
    g.A = p.hn; g.Bt = p.wt_up; g.lda = DM; g.ldb = DM; g.row0 = row0; g.rlo = b * SEQ; g.rhi = b * SEQ + SEQ - 1; g.col0 = nt * 128;
    {
      const int bn = mtn / 33, itn = mtn % 33;
      gn = g; gn.row0 = bn * SEQ + itn * 126 - 2; gn.rlo = bn * SEQ; gn.rhi = bn * SEQ + SEQ - 1; gn.col0 = ntn * 128;
    }
    f32x4 acc[4][4];
    gemm_mainloop<false>(g, gn, has_next, t == bid, DM, lds, acc);
    asm volatile("s_waitcnt lgkmcnt(0)" ::: "memory");
    __builtin_amdgcn_s_barrier();
    asm volatile("" ::: "memory");
#pragma unroll
    for (int m = 0; m < 4; ++m)
#pragma unroll
      for (int n = 0; n < 2; ++n) {
        const int r = wr * 64 + m * 16 + fr;
        const int c16 = wc * 8 + n * 4 + fq;
        *(f32x4*)(sAct + r * 256 + ((c16 ^ (r & 15)) << 4)) = acc[m][n];
      }
    asm volatile("s_waitcnt lgkmcnt(0)" ::: "memory");
    __builtin_amdgcn_s_barrier();
    asm volatile("" ::: "memory");
#pragma unroll
    for (int n = 0; n < 2; ++n) {
      const int c16 = wc * 8 + n * 4 + fq;
      const int fc = nt * 64 + c16 * 4;
      const f32x4 w0 = *(const f32x4*)(cw + fc), w1 = *(const f32x4*)(cw + DFF + fc), w2 = *(const f32x4*)(cw + 2 * DFF + fc);
      const f32x4 bb = *(const f32x4*)(cb + fc);
#pragma unroll
      for (int m = 0; m < 4; ++m) {
        const int r = wr * 64 + m * 16 + fr;
        const int pos = p0 - 2 + r;
        if (r >= 2 && pos < SEQ) {
          const f32x4 a0 = acc[m][n];
          f32x4 a1 = *(const f32x4*)(sAct + (r - 1) * 256 + ((c16 ^ ((r - 1) & 15)) << 4));
          f32x4 a2 = *(const f32x4*)(sAct + (r - 2) * 256 + ((c16 ^ ((r - 2) & 15)) << 4));
          if (pos < 1) a1 = (f32x4){0.f, 0.f, 0.f, 0.f};
          if (pos < 2) a2 = (f32x4){0.f, 0.f, 0.f, 0.f};
          float hv[4];
#pragma unroll
          for (int j = 0; j < 4; ++j) {
            const float xv = w2[j] * a0[j] + w1[j] * a1[j] + w0[j] * a2[j] + bb[j];
            const float u = 0.7978845608028654f * (xv + 0.044715f * xv * xv * xv);
            const float gl = xv * __builtin_amdgcn_rcpf(1.f + fexp2(-2.f * LOG2E * u));
            hv[j] = gl * acc[m][n + 2][j];
          }
          u32x2 w;
          w.x = pack2(hv[0], hv[1]);
          w.y = pack2(hv[2], hv[3]);
          *(u32x2*)(p.hbuf + (size_t)(b * SEQ + pos) * DFF + fc) = w;
        }
      }
    }
  }
}

__device__ __forceinline__ float wave_sum(float v) {
#pragma unroll
  for (int o = 32; o > 0; o >>= 1) v += __shfl_xor(v, o);
  return v;
}
__device__ __forceinline__ f32x4 ld_mod4(const float* ptr) {
  return ((*(const f32x4*)ptr + *(const f32x4*)(ptr + MOD_PLANE)) + *(const f32x4*)(ptr + 2 * MOD_PLANE)) + *(const f32x4*)(ptr + 3 * MOD_PLANE);
}
__device__ __forceinline__ void rowpass_phase(const float* xsrc, const bf16_t* y, const float* gate, const float* postg, float* xdst,
                              const float* preg, const float* sc, const float* sh, bf16_t* hn, int nb, int bid) {
  const int lane = OTID() & 63, wid = UWID(OTID());
  const int rpw = (NTOK + nb * 4 - 1) / (nb * 4);
  const int rbeg = (bid * 4 + wid) * rpw;
  if (rbeg >= NTOK) return;
  const int rend = rbeg + rpw < NTOK ? rbeg + rpw : NTOK;
  const int b = rbeg >> 12;
  f32x4 vg[4], vpg[4], vpre[4], vsc[4], vsh[4];
#pragma unroll
  for (int i = 0; i < 4; ++i) {
    const int col = i * 256 + lane * 4;
    if (y) { vg[i] = ld_mod4(gate + b * 6144 + col); vpg[i] = *(const f32x4*)(postg + col); }
    if (hn) { vpre[i] = *(const f32x4*)(preg + col); vsc[i] = ld_mod4(sc + b * 6144 + col) + 1.f; vsh[i] = ld_mod4(sh + b * 6144 + col); }
  }
  for (int row0 = rbeg; row0 < rend; row0 += 2) {
    f32x4 xv[2][4];
    u32x2 yr[2][4];
#pragma unroll
    for (int rr = 0; rr < 2; ++rr) {
      const int row = row0 + rr;
      if (row < rend) {
#pragma unroll
        for (int i = 0; i < 4; ++i) xv[rr][i] = __builtin_nontemporal_load((const f32x4*)(xsrc + (size_t)row * DM + i * 256 + lane * 4));
        if (y) {
#pragma unroll
          for (int i = 0; i < 4; ++i) yr[rr][i] = __builtin_nontemporal_load((const u32x2*)(y + (size_t)row * DM + i * 256 + lane * 4));
        }
      }
    }
#pragma unroll
    for (int rr = 0; rr < 2; ++rr) {
      const int row = row0 + rr;
      if (row < rend) {
        if (y) {
          f32x4 yv[4];
          float ss = 0.f;
#pragma unroll
          for (int i = 0; i < 4; ++i) {
            yv[i][0] = __uint_as_float(yr[rr][i].x << 16);
            yv[i][1] = __uint_as_float(yr[rr][i].x & 0xffff0000u);
            yv[i][2] = __uint_as_float(yr[rr][i].y << 16);
            yv[i][3] = __uint_as_float(yr[rr][i].y & 0xffff0000u);
            ss += yv[i][0] * yv[i][0] + yv[i][1] * yv[i][1] + yv[i][2] * yv[i][2] + yv[i][3] * yv[i][3];
          }
          ss = wave_sum(ss);
          const float r = rsqrtf(ss * (1.f / DM) + EPSF);
#pragma unroll
          for (int i = 0; i < 4; ++i) {
            xv[rr][i] = xv[rr][i] + vg[i] * (yv[i] * r) * vpg[i];
            __builtin_nontemporal_store(xv[rr][i], (f32x4*)(xdst + (size_t)row * DM + i * 256 + lane * 4));
          }
        }
        if (hn) {
          float ss = 0.f;
#pragma unroll
          for (int i = 0; i < 4; ++i) ss += xv[rr][i][0] * xv[rr][i][0] + xv[rr][i][1] * xv[rr][i][1] + xv[rr][i][2] * xv[rr][i][2] + xv[rr][i][3] * xv[rr][i][3];
          ss = wave_sum(ss);
          const float r = rsqrtf(ss * (1.f / DM) + EPSF);
#pragma unroll
          for (int i = 0; i < 4; ++i) {
            f32x4 h = (xv[rr][i] * r) * vpre[i] * vsc[i] + vsh[i];
            u32x2 w;
            w.x = pack2(h[0], h[1]);
            w.y = pack2(h[2], h[3]);
            *(u32x2*)(hn + (size_t)row * DM + i * 256 + lane * 4) = w;
          }
        }
      }
    }
  }
}

struct CvtDesc { const float* src; bf16_t* dst; int N, K, k0, ndst0, nsA, nsB; };
__device__ __forceinline__ CvtDesc cvt_decode(KParams& p, int l, int it) {
  const int n_in = 16 * 60, n_out = 16 * 16, n_up = 16 * 88;
  CvtDesc d;
  int i = it;
  if (i < n_in) {
    const int kt = i % 16, ntile = i / 16, ns = ntile * 64;
    d.src = p.w_in + (size_t)l * DM * IN_COLS; d.dst = p.wt_in; d.N = IN_COLS; d.K = DM; d.k0 = kt * 64; d.ndst0 = ns;
    d.nsA = ns < IN_COLS ? ns : -1; d.nsB = ns + 32 < IN_COLS ? ns + 32 : -1;
    return d;
  }
  i -= n_in;
  if (i < n_out) {
    const int kt = i % 16, ntile = i / 16;
    d.src = p.w_out + (size_t)l * DM * DM; d.dst = p.wt_out; d.N = DM; d.K = DM; d.k0 = kt * 64; d.ndst0 = ntile * 64; d.nsA = ntile * 64; d.nsB = ntile * 64 + 32;
    return d;
  }
  i -= n_out;
  if (i < n_up) {
    const int kt = i % 16, q = i / 16;
    const int j = q >> 1, wcv = q & 1;
    d.src = p.w_up + (size_t)l * DM * 2 * DFF; d.dst = p.wt_up; d.N = 2 * DFF; d.K = DM; d.k0 = kt * 64; d.ndst0 = q * 64;
    d.nsA = j * 64 + wcv * 32; d.nsB = DFF + j * 64 + wcv * 32;
    return d;
  }
  i -= n_up;
  {
    const int kt = i % 44, ntile = i / 44;
    d.src = p.w_down + (size_t)l * DFF * DM; d.dst = p.wt_down; d.N = DM; d.K = DFF; d.k0 = kt * 64; d.ndst0 = ntile * 64; d.nsA = ntile * 64; d.nsB = ntile * 64 + 32;
    return d;
  }
}
__device__ __forceinline__ void cvt_load(const CvtDesc& d, int tid, f32x4 (&v)[4]) {
  const int c4 = (tid & 15) * 4, r = tid >> 4;
  const int ns = c4 < 32 ? d.nsA : d.nsB;
  const int sc = ns + (c4 & 31);
  const bool ok = ns >= 0 && sc < d.N;
#pragma unroll
  for (int ps = 0; ps < 4; ++ps) {
    v[ps] = (f32x4){0.f, 0.f, 0.f, 0.f};
    if (ok) v[ps] = __builtin_nontemporal_load((const f32x4*)(d.src + (size_t)(d.k0 + r + 16 * ps) * d.N + sc));
  }
}

__device__ __forceinline__ void convert_weights_phase(KParams& p, int l, unsigned char* lds, int stride, int first, int lo, int hi) {
  float* tiles = (float*)lds;
  const int total = hi;
  const int tid = OTID();
  const int nb = stride, bid = lo + first;
  if (first < 0 || bid >= total) return;
  CvtDesc cur = cvt_decode(p, l, bid);
  f32x4 v[4];
  cvt_load(cur, tid, v);
  int par = 0;
  __syncthreads();
  for (int it = bid; it < total; it += nb) {
    float* tile = tiles + par * (64 * 65);
    {
      const int c4 = (tid & 15) * 4, r = tid >> 4;
#pragma unroll
      for (int ps = 0; ps < 4; ++ps) {
        const int k = r + 16 * ps;
        tile[k * 65 + c4 + 0] = v[ps][0];
        tile[k * 65 + c4 + 1] = v[ps][1];
        tile[k * 65 + c4 + 2] = v[ps][2];
        tile[k * 65 + c4 + 3] = v[ps][3];
      }
    }
    __syncthreads();
    const CvtDesc me = cur;
    if (it + nb < total) { cur = cvt_decode(p, l, it + nb); cvt_load(cur, tid, v); }
    {
      const int n = tid >> 2, kc = (tid & 3) * 16;
      unsigned w[8];
#pragma unroll
      for (int i = 0; i < 8; ++i) w[i] = pack2(tile[(kc + 2 * i) * 65 + n], tile[(kc + 2 * i + 1) * 65 + n]);
      u32x4* dd = (u32x4*)(me.dst + (size_t)(me.ndst0 + n) * me.K + me.k0 + kc);
      dd[0] = (u32x4){w[0], w[1], w[2], w[3]};
      dd[1] = (u32x4){w[4], w[5], w[6], w[7]};
    }
    par ^= 1;
  }
  __syncthreads();
}

__device__ __forceinline__ void mod_phase(KParams& p, unsigned char* lds, int nb, int bid) {
  float* sc_ = (float*)lds;
  float* red = sc_ + 4096;
  const int tid = OTID(), lane = tid & 63, wid = UWID(tid);
  for (int it = bid; it < 192; it += nb) {
    const int l = it / 96, rem = it % 96, cc = (rem >> 2) * 256, kq = rem & 3;
    __syncthreads();
    {
      f32x4 cv[4];
#pragma unroll
      for (int j = 0; j < 4; ++j) cv[j] = *(const f32x4*)(p.c + tid * 16 + j * 4);
#pragma unroll
      for (int j = 0; j < 4; ++j) {
        f32x4 r;
        r[0] = siluf(cv[j][0]); r[1] = siluf(cv[j][1]); r[2] = siluf(cv[j][2]); r[3] = siluf(cv[j][3]);
        *(f32x4*)(sc_ + tid * 16 + j * 4) = r;
      }
    }
    __syncthreads();
    const float* w = p.ada_w + (size_t)l * DM * 6144 + cc + lane * 4;
    f32x4 a0 = (f32x4){0.f, 0.f, 0.f, 0.f}, a1 = a0, a2 = a0, a3 = a0;
    const int kb = kq * 256 + wid * 64;
#pragma unroll 32
    for (int k = kb; k < kb + 64; ++k) {
      const f32x4 wv = __builtin_nontemporal_load((const f32x4*)(w + (size_t)k * 6144));
      a0 += wv * sc_[k];
      a1 += wv * sc_[1024 + k];
      a2 += wv * sc_[2048 + k];
      a3 += wv * sc_[3072 + k];
    }
    *(f32x4*)(red + (wid * 4 + 0) * 256 + lane * 4) = a0;
    *(f32x4*)(red + (wid * 4 + 1) * 256 + lane * 4) = a1;
    *(f32x4*)(red + (wid * 4 + 2) * 256 + lane * 4) = a2;
    *(f32x4*)(red + (wid * 4 + 3) * 256 + lane * 4) = a3;
    __syncthreads();
    {
      const int b = wid;
      f32x4 sv = (*(const f32x4*)(red + (0 * 4 + b) * 256 + lane * 4) + *(const f32x4*)(red + (1 * 4 + b) * 256 + lane * 4)) +
                 (*(const f32x4*)(red + (2 * 4 + b) * 256 + lane * 4) + *(const f32x4*)(red + (3 * 4 + b) * 256 + lane * 4));
      if (kq == 0) sv += *(const f32x4*)(p.ada_b + (size_t)l * 6144 + cc + lane * 4);
      *(f32x4*)(p.mod + (size_t)kq * MOD_PLANE + (size_t)(l * 4 + b) * 6144 + cc + lane * 4) = sv;
    }
  }
}

__device__ __forceinline__ void sb_item(KParams& p, int b, int h, int qt, unsigned char* lds) {
  bf16_t* sK = (bf16_t*)lds;
  bf16_t* sV = sK + 64 * LSTR;
  volatile int* sFlag = (volatile int*)(sV + 64 * LSTR);
  const int tid = OTID(), lane = tid & 63, wid = UWID(tid), fr = lane & 15, fq = lane >> 4;
  const int sr = tid >> 3, sc8 = (tid & 7) * 8;
  const size_t tokq = (size_t)b * SEQ + qt * 64 + wid * 16 + fr;
  bf16x8 qf[2];
#pragma unroll
  for (int ks = 0; ks < 2; ++ks) qf[ks] = *(const bf16x8*)(p.sq + tokq * 384 + h * 64 + ks * 32 + fq * 8);
  f32x4 o[4];
#pragma unroll
  for (int n = 0; n < 4; ++n) o[n] = (f32x4){0.f, 0.f, 0.f, 0.f};
  float carry = 0.f;
  const int tq = qt * 64 + wid * 16 + fr;
  const bf16_t* kbase = p.sk + ((size_t)b * SEQ) * 384 + h * 64 + sc8;
  const bf16_t* vbase = p.svt + ((size_t)(b * 6 + h) * 64) * SEQ + sc8;
  u32x4 kreg[2], vreg[2];
#pragma unroll
  for (int i = 0; i < 2; ++i) {
    kreg[i] = *(const u32x4*)(kbase + (size_t)(qt * 64 + sr + 32 * i) * 384);
    vreg[i] = *(const u32x4*)(vbase + (size_t)(sr + 32 * i) * SEQ + qt * 64);
  }
  __syncthreads();
  for (int kt = qt; kt >= 0; --kt) {
#pragma unroll
    for (int i = 0; i < 2; ++i) {
      *(u32x4*)(sK + (sr + 32 * i) * LSTR + sc8) = kreg[i];
      *(u32x4*)(sV + (sr + 32 * i) * LSTR + sc8) = vreg[i];
    }
    __syncthreads();
    if (kt > 0) {
#pragma unroll
      for (int i = 0; i < 2; ++i) {
        kreg[i] = *(const u32x4*)(kbase + (size_t)((kt - 1) * 64 + sr + 32 * i) * 384);
        vreg[i] = *(const u32x4*)(vbase + (size_t)(sr + 32 * i) * SEQ + (kt - 1) * 64);
      }
    }
    f32x4 z[4];
#pragma unroll
    for (int m = 0; m < 4; ++m) {
      z[m] = (f32x4){0.f, 0.f, 0.f, 0.f};
#pragma unroll
      for (int ks = 0; ks < 2; ++ks) {
        const bf16x8 kf = *(const bf16x8*)(sK + (m * 16 + fr) * LSTR + ks * 32 + fq * 8);
        z[m] = mfma16(kf, qf[ks], z[m]);
      }
    }
    float lk[4][4], lb[4][4];
    const bool diag = (kt == qt);
#pragma unroll
    for (int m = 0; m < 4; ++m)
#pragma unroll
      for (int j = 0; j < 4; ++j) {
        const float zz = z[m][j];
        const float sp = fmaxf(zz, 0.f) + flog2(1.f + fexp2(-fabsf(zz)));
        const int s = kt * 64 + m * 16 + fq * 4 + j;
        const bool valid = (!diag) || (s < tq);
        lk[m][j] = valid ? -sp : 0.f;
        lb[m][j] = valid ? (zz - sp) : -1e30f;
      }
    float tot[4], ex[4];
#pragma unroll
    for (int m = 0; m < 4; ++m) {
      const float s4 = (lk[m][0] + lk[m][1]) + (lk[m][2] + lk[m][3]);
      const float bb = __shfl_xor(s4, 16);
      const float cc = s4 + bb;
      const float dd = __shfl_xor(cc, 32);
      tot[m] = cc + dd;
      ex[m] = ((fq & 1) ? 0.f : bb) + ((fq & 2) ? 0.f : dd);
    }
    float a[4][4];
    float base = carry;
#pragma unroll
    for (int m = 3; m >= 0; --m) {
      float run = base + ex[m];
#pragma unroll
      for (int j = 3; j >= 0; --j) {
        a[m][j] = fexp2(lb[m][j] + run);
        run += lk[m][j];
      }
      base += tot[m];
    }
    carry = base;
#pragma unroll
    for (int u = 0; u < 2; ++u) {
      U4B8 pa;
      pa.u.x = pack2(a[2 * u][0], a[2 * u][1]);
      pa.u.y = pack2(a[2 * u][2], a[2 * u][3]);
      pa.u.z = pack2(a[2 * u + 1][0], a[2 * u + 1][1]);
      pa.u.w = pack2(a[2 * u + 1][2], a[2 * u + 1][3]);
#pragma unroll
      for (int n = 0; n < 4; ++n) {
        U2x2B8 vf;
        vf.u[0] = *(const u32x2*)(sV + (n * 16 + fr) * LSTR + u * 32 + fq * 4);
        vf.u[1] = *(const u32x2*)(sV + (n * 16 + fr) * LSTR + u * 32 + 16 + fq * 4);
        o[n] = mfma16(pa.v, vf.v, o[n]);
      }
    }
    {
      const int wdone = __all(carry < -180.f) ? 1 : 0;
      if (lane == 0) sFlag[wid] = wdone;
      __syncthreads();
      if (sFlag[0] & sFlag[1] & sFlag[2] & sFlag[3]) break;
    }
  }
  bf16_t* ob = p.hn + ((size_t)b * SEQ + qt * 64 + wid * 16) * DM + 384 + h * 64;
#pragma unroll
  for (int n = 0; n < 4; ++n)
#pragma unroll
    for (int j = 0; j < 4; ++j) ob[(size_t)(fq * 4 + j) * DM + n * 16 + fr] = f2bf(o[n][j]);
}

__device__ __forceinline__ void lin_prep(KParams& p, int l, int b, int g, int ic, float (&bc)[16], float& blast, float* sGlr, float* sTot) {
  const int tid = OTID(), lane = tid & 63, wid = UWID(tid);
  if (g < 6) {
    const float lg = LOG_GAMMA[g];
#pragma unroll
    for (int r = 0; r < 16; ++r) bc[r] = (float)(16 * wid + r + 1) * lg;
    blast = 64.f * lg;
  } else {
    const size_t T0 = (size_t)b * SEQ + ic * 64;
    *(f32x4*)(sGlr + tid * 4) = *(const f32x4*)(p.glr + T0 * 16 + tid * 4);
    const int c = (g - 6) * 64 + lane;
    float w2r[16];
#pragma unroll
    for (int rr = 0; rr < 16; ++rr) w2r[rr] = p.gla_w2[((size_t)l * 16 + rr) * 256 + c];
    const float gb = p.gla_b[(size_t)l * 256 + c];
    __syncthreads();
    float run = 0.f;
#pragma unroll
    for (int r = 0; r < 16; ++r) {
      const int t = 16 * wid + r;
      float xv = gb;
#pragma unroll
      for (int rr = 0; rr < 16; ++rr) xv += sGlr[t * 16 + rr] * w2r[rr];
      const float ls = -(fmaxf(-xv, 0.f) + __logf(1.f + __expf(-fabsf(xv))));
      run += ls * (1.f / 16.f);
      bc[r] = run;
    }
    sTot[wid * 64 + lane] = run;
    __syncthreads();
    float off = 0.f, tt = 0.f;
#pragma unroll
    for (int w = 0; w < 4; ++w) {
      const float v = sTot[w * 64 + lane];
      tt += v;
      if (w < wid) off += v;
    }
#pragma unroll
    for (int r = 0; r < 16; ++r) bc[r] += off;
    blast = tt;
  }
}

__device__ __forceinline__ void lin_kv_item(KParams& p, int l, int b, int g, int ic, unsigned char* lds) {
  bf16_t* sKT = (bf16_t*)lds;
  bf16_t* sV = sKT + 64 * LSTR;
  float* sGlr = (float*)(sV + 64 * LSTR);
  float* sTot = sGlr + 1024;
  const int tid = OTID(), lane = tid & 63, wid = UWID(tid), fr = lane & 15, fq = lane >> 4;
  const int bg = b * 10 + g;
  const size_t T0 = (size_t)b * SEQ + ic * 64;
  __syncthreads();
  bf16_t kraw[16];
  u32x4 vreg[2];
  {
#pragma unroll
    for (int r = 0; r < 16; ++r) kraw[r] = p.lk[(T0 + 16 * wid + r) * 640 + g * 64 + lane];
    const int sr = tid >> 3, sc8 = (tid & 7) * 8;
#pragma unroll
    for (int i = 0; i < 2; ++i) vreg[i] = *(const u32x4*)(p.lvt + ((size_t)bg * 64 + sr + 32 * i) * SEQ + ic * 64 + sc8);
  }
  float bc[16], blast;
  lin_prep(p, l, b, g, ic, bc, blast, sGlr, sTot);
  {
    unsigned w[8];
#pragma unroll
    for (int r = 0; r < 16; r += 2) {
      const float k0 = bf2f(kraw[r]);
      const float k1 = bf2f(kraw[r + 1]);
      w[r >> 1] = pack2(k0 * __expf(blast - bc[r]), k1 * __expf(blast - bc[r + 1]));
    }
    u32x4* d = (u32x4*)(sKT + lane * LSTR + 16 * wid);
    d[0] = (u32x4){w[0], w[1], w[2], w[3]};
    d[1] = (u32x4){w[4], w[5], w[6], w[7]};
  }
  {
    const int sr = tid >> 3, sc8 = (tid & 7) * 8;
#pragma unroll
    for (int i = 0; i < 2; ++i) *(u32x4*)(sV + (sr + 32 * i) * LSTR + sc8) = vreg[i];
  }
  __syncthreads();
  float* kvo = p.kvt + ((size_t)bg * 64 + ic) * 4096;
#pragma unroll
  for (int ne = 0; ne < 4; ++ne) {
    f32x4 acc = (f32x4){0.f, 0.f, 0.f, 0.f};
#pragma unroll
    for (int ks = 0; ks < 2; ++ks) {
      const bf16x8 af = *(const bf16x8*)(sKT + (wid * 16 + fr) * LSTR + ks * 32 + fq * 8);
      const bf16x8 bf = *(const bf16x8*)(sV + (ne * 16 + fr) * LSTR + ks * 32 + fq * 8);
      acc = mfma16(af, bf, acc);
    }
    __builtin_nontemporal_store(acc, (f32x4*)(kvo + (ne * 16 + fr) * 64 + wid * 16 + fq * 4));
  }
  if (wid == 0) p.bl[((size_t)bg * 64 + ic) * 64 + lane] = blast;
}

__device__ __forceinline__ void lin_scan_phase(KParams& p, int nb, int bid) {
  const int tid = OTID();
  const int total = 40 * 4096;
  const int per = (total + nb - 1) / nb;
  const int lo = bid * per, hi = lo + per < total ? lo + per : total;
  for (int base = lo; base < hi; base += 512) {
    const int e0 = base + tid, e1 = base + 256 + tid;
    const bool a0 = e0 < hi, a1 = e1 < hi;
    const int ee0 = a0 ? e0 : lo, ee1 = a1 ? e1 : lo;
    const int bg0 = ee0 >> 12, bg1 = ee1 >> 12;
    const int i0x = ee0 & 4095, i1x = ee1 & 4095;
    const float* kv0 = p.kvt + (size_t)bg0 * 64 * 4096 + i0x;
    const float* kv1 = p.kvt + (size_t)bg1 * 64 * 4096 + i1x;
    const float* bl0 = p.bl + (size_t)bg0 * 64 * 64 + (i0x & 63);
    const float* bl1 = p.bl + (size_t)bg1 * 64 * 64 + (i1x & 63);
    bf16_t* so0 = p.st + (size_t)bg0 * 64 * 4096 + i0x;
    bf16_t* so1 = p.st + (size_t)bg1 * 64 * 4096 + i1x;
    float s0 = 0.f, s1 = 0.f;
#pragma nounroll
    for (int c0 = 0; c0 < 64; c0 += 16) {
      float kva[16], da[16], kvb[16], db[16];
#pragma unroll
      for (int i = 0; i < 16; ++i) {
        kva[i] = __builtin_nontemporal_load(kv0 + (size_t)(c0 + i) * 4096);
        da[i] = bl0[(c0 + i) * 64];
      }
      if (a1) {
#pragma unroll
        for (int i = 0; i < 16; ++i) {
          kvb[i] = __builtin_nontemporal_load(kv1 + (size_t)(c0 + i) * 4096);
          db[i] = bl1[(c0 + i) * 64];
        }
      }
      if (a0) {
#pragma unroll
        for (int i = 0; i < 16; ++i) {
          so0[(size_t)(c0 + i) * 4096] = f2bf(s0);
          s0 = __expf(da[i]) * s0 + kva[i];
        }
      }
      if (a1) {
#pragma unroll
        for (int i = 0; i < 16; ++i) {
          so1[(size_t)(c0 + i) * 4096] = f2bf(s1);
          s1 = __expf(db[i]) * s1 + kvb[i];
        }
      }
    }
  }
}

__device__ __forceinline__ void lin_out_item(KParams& p, int l, int b, int g, int ic, unsigned char* lds) {
  bf16_t* sQp = (bf16_t*)lds;
  bf16_t* sQm = sQp + 64 * LSTR;
  bf16_t* sKp = sQm + 64 * LSTR;
  bf16_t* sKm = sKp + 64 * LSTR;
  bf16_t* sV = sKm + 64 * LSTR;
  bf16_t* sS = sV + 64 * LSTR;
  float* sGlr = (float*)(sS + 64 * LSTR);
  float* sTot = sGlr + 1024;
  const int tid = OTID(), lane = tid & 63, wid = UWID(tid), fr = lane & 15, fq = lane >> 4;
  const int bg = b * 10 + g;
  const size_t T0 = (size_t)b * SEQ + ic * 64;
  __syncthreads();
  bf16_t qraw[16], kraw[16];
  u32x4 vreg[2], sreg[2];
  {
#pragma unroll
    for (int r = 0; r < 16; ++r) {
      qraw[r] = p.lq[(T0 + 16 * wid + r) * 640 + g * 64 + lane];
      kraw[r] = p.lk[(T0 + 16 * wid + r) * 640 + g * 64 + lane];
    }
    const int sr = tid >> 3, sc8 = (tid & 7) * 8;
#pragma unroll
    for (int i = 0; i < 2; ++i) {
      vreg[i] = *(const u32x4*)(p.lvt + ((size_t)bg * 64 + sr + 32 * i) * SEQ + ic * 64 + sc8);
      sreg[i] = __builtin_nontemporal_load((const u32x4*)(p.st + ((size_t)bg * 64 + ic) * 4096 + (sr + 32 * i) * 64 + sc8));
    }
  }
  bf16_t graw[4][4];
  float gamv[4];
  {
    const float* gam0 = (g < 6) ? (p.ret_norm_g + (size_t)l * 384 + g * 64) : (p.gla_norm_g + (size_t)l * 256 + (g - 6) * 64);
#pragma unroll
    for (int ne = 0; ne < 4; ++ne) {
      gamv[ne] = gam0[ne * 16 + fr];
#pragma unroll
      for (int j = 0; j < 4; ++j) graw[j][ne] = p.lg[(T0 + wid * 16 + fq * 4 + j) * 640 + g * 64 + ne * 16 + fr];
    }
  }
  float bc[16], blast;
  lin_prep(p, l, b, g, ic, bc, blast, sGlr, sTot);
#pragma unroll
  for (int r = 0; r < 16; ++r) {
    const int t = 16 * wid + r;
    const float qv = bf2f(qraw[r]);
    const float kv = bf2f(kraw[r]);
    const float ep = __expf(bc[r]), em = __expf(-bc[r]);
    sQp[t * LSTR + lane] = f2bf(qv * ep);
    sQm[t * LSTR + lane] = f2bf(qv * em);
    sKp[t * LSTR + lane] = f2bf(kv * ep);
    sKm[t * LSTR + lane] = f2bf(kv * em);
  }
  {
    const int sr = tid >> 3, sc8 = (tid & 7) * 8;
#pragma unroll
    for (int i = 0; i < 2; ++i) {
      *(u32x4*)(sV + (sr + 32 * i) * LSTR + sc8) = vreg[i];
      *(u32x4*)(sS + (sr + 32 * i) * LSTR + sc8) = sreg[i];
    }
  }
  __syncthreads();
  bf16x8 qpf[2], qmf[2];
#pragma unroll
  for (int ks = 0; ks < 2; ++ks) {
    qpf[ks] = *(const bf16x8*)(sQp + (wid * 16 + fr) * LSTR + ks * 32 + fq * 8);
    qmf[ks] = *(const bf16x8*)(sQm + (wid * 16 + fr) * LSTR + ks * 32 + fq * 8);
  }
  float P[4][4];
#pragma unroll
  for (int ms = 0; ms < 4; ++ms) {
    f32x4 lo = (f32x4){0.f, 0.f, 0.f, 0.f}, up = (f32x4){0.f, 0.f, 0.f, 0.f};
#pragma unroll
    for (int ks = 0; ks < 2; ++ks) {
      const bf16x8 kmf = *(const bf16x8*)(sKm + (ms * 16 + fr) * LSTR + ks * 32 + fq * 8);
      const bf16x8 kpf = *(const bf16x8*)(sKp + (ms * 16 + fr) * LSTR + ks * 32 + fq * 8);
      lo = mfma16(kmf, qpf[ks], lo);
      up = mfma16(kpf, qmf[ks], up);
    }
#pragma unroll
    for (int j = 0; j < 4; ++j) {
      const int s = ms * 16 + fq * 4 + j, t = wid * 16 + fr;
      P[ms][j] = (t >= s) ? lo[j] : up[j];
    }
  }
  f32x4 o[4];
#pragma unroll
  for (int ne = 0; ne < 4; ++ne) o[ne] = (f32x4){0.f, 0.f, 0.f, 0.f};
#pragma unroll
  for (int u = 0; u < 2; ++u) {
    U4B8 pa;
    pa.u.x = pack2(P[2 * u][0], P[2 * u][1]);
    pa.u.y = pack2(P[2 * u][2], P[2 * u][3]);
    pa.u.z = pack2(P[2 * u + 1][0], P[2 * u + 1][1]);
    pa.u.w = pack2(P[2 * u + 1][2], P[2 * u + 1][3]);
#pragma unroll
    for (int ne = 0; ne < 4; ++ne) {
      U2x2B8 vf;
      vf.u[0] = *(const u32x2*)(sV + (ne * 16 + fr) * LSTR + u * 32 + fq * 4);
      vf.u[1] = *(const u32x2*)(sV + (ne * 16 + fr) * LSTR + u * 32 + 16 + fq * 4);
      o[ne] = mfma16(pa.v, vf.v, o[ne]);
    }
  }
#pragma unroll
  for (int ks = 0; ks < 2; ++ks)
#pragma unroll
    for (int ne = 0; ne < 4; ++ne) {
      const bf16x8 sf = *(const bf16x8*)(sS + (ne * 16 + fr) * LSTR + ks * 32 + fq * 8);
      o[ne] = mfma16(qpf[ks], sf, o[ne]);
    }
  const bool isret = (g < 6);
  const int mixcol = isret ? g * 64 : 768 + (g - 6) * 64;
#pragma unroll
  for (int j = 0; j < 4; ++j) {
    float s1 = (o[0][j] + o[1][j]) + (o[2][j] + o[3][j]);
#pragma unroll
    for (int of = 8; of > 0; of >>= 1) s1 += __shfl_xor(s1, of);
    const float mu = isret ? s1 * (1.f / 64.f) : 0.f;
    float s2 = 0.f;
#pragma unroll
    for (int ne = 0; ne < 4; ++ne) { const float dv = o[ne][j] - mu; s2 += dv * dv; }
#pragma unroll
    for (int of = 8; of > 0; of >>= 1) s2 += __shfl_xor(s2, of);
    const float rs = rsqrtf(s2 * (1.f / 64.f) + EPSF);
    const size_t tok = T0 + wid * 16 + fq * 4 + j;
#pragma unroll
    for (int ne = 0; ne < 4; ++ne) {
      const int e = ne * 16 + fr;
      const float gate = bf2f(graw[j][ne]);
      p.hn[tok * DM + mixcol + e] = f2bf((o[ne][j] - mu) * rs * gamv[ne] * gate);
    }
  }
}

__device__ __forceinline__ void run_phase(KParams& p, int ph, int l, unsigned char* lds, int nb, int bid) {
  const float* modl = p.mod + (size_t)l * 4 * 6144;
  switch (ph) {
    case 0:
      {
        const int CT = 16 * 60 + 16 * 16 + 16 * 88 + 44 * 16;
        const int nmod = nb > 192 ? 192 : 0;
        const int partA = nmod ? 5 * (nb - nmod) : 0;
        if (nmod == 0 || bid < nmod) mod_phase(p, lds, nb, bid);
        else convert_weights_phase(p, 0, lds, nb - nmod, bid - nmod, 0, partA < CT ? partA : CT);
        if (partA < CT) convert_weights_phase(p, 0, lds, nb, bid, partA, CT);
      }
      break;
    case 1:
      rowpass_phase(p.x, nullptr, nullptr, nullptr, nullptr, p.pre_mix_g, p.mod + 1024, p.mod, p.hn, nb, bid);
      break;
    case 2:
      proj_phase(p, l, lds, nb, bid);
      break;
    case 3:
      for (int it = bid; it < 2560; it += nb) lin_kv_item(p, l, it / 640, (it / 64) % 10, it & 63, lds);
      break;
    case 4:
      lin_scan_phase(p, nb, bid);
      break;
    case 5:
      for (int it = bid; it < 1536 + 2560; it += nb) {
        if (it < 1536) {
          sb_item(p, (it % 24) / 6, it % 6, 63 - it / 24, lds);
        } else {
          const int i2 = it - 1536;
          lin_out_item(p, l, i2 / 640, (i2 / 64) % 10, i2 & 63, lds);
        }
      }
      break;
    case 6:
      gemm_y_phase(p, p.hn, DM, p.wt_out, lds, nb, bid);
      break;
    case 7:
      rowpass_phase(l == 0 ? p.x : p.out, p.y, modl + 2048, p.post_mix_g + (size_t)l * DM, p.out, p.pre_ffn_g + (size_t)l * DM,
                    modl + 4096, modl + 3072, p.hn, nb, bid);
      break;
    case 8:
      up_phase(p, l, lds, nb, bid);
      break;
    case 9:
      gemm_y_phase(p, p.hbuf, DFF, p.wt_down, lds, nb, bid);
      break;
    case 10:
      if (l == 0) {
        rowpass_phase(p.out, p.y, modl + 5120, p.post_ffn_g, p.out, p.pre_mix_g + DM, p.mod + 4 * 6144 + 1024, p.mod + 4 * 6144, p.hn, nb, bid);
        convert_weights_phase(p, 1, lds, nb, bid, 0, 16 * 60 + 16 * 16 + 16 * 88 + 44 * 16);
      } else {
        rowpass_phase(p.out, p.y, modl + 5120, p.post_ffn_g + DM, p.out, nullptr, nullptr, nullptr, nullptr, nb, bid);
      }
      break;
  }
}


#define XB_TMO      128
#define XB_XCNT(j)  (256  + 64 * (j))
#define XB_XSUB(j)  (1280 + 64 * (j))
#define XB_XGEN(j)  (2304 + 64 * (j))
#define XB_TOP      3328
#define XB_TOPGEN   3392
#define XCD_BAR_WORDS 3456
#define XB_SPIN_CAP (1u << 20)
#define LAS __attribute__((address_space(3)))
__device__ __forceinline__ unsigned xb_ld(unsigned* p)              { return __hip_atomic_load(p, __ATOMIC_RELAXED, __HIP_MEMORY_SCOPE_AGENT); }
__device__ __forceinline__ unsigned xb_add(unsigned* p, unsigned v) { return __hip_atomic_fetch_add(p, v, __ATOMIC_RELAXED, __HIP_MEMORY_SCOPE_AGENT); }
__device__ __forceinline__ unsigned xb_xcc_id() { return (unsigned)__builtin_amdgcn_s_getreg((3 << 11) | 20) & 0xFu; }
#define XB_SPIN(cond, bar) do { unsigned _sp = 0; while (cond) { __builtin_amdgcn_s_sleep(1); \
    if ((++_sp & 255u) == 0u) { if (xb_ld(&(bar)[XB_TMO])) break; if (_sp > XB_SPIN_CAP) { atomicAdd(&(bar)[XB_TMO], 1u); break; } } } } while (0)
struct XcdBarrier { unsigned* bar; unsigned x; volatile LAS unsigned* st; };
__device__ __forceinline__ XcdBarrier xcd_barrier_post(unsigned* bar, volatile LAS unsigned* st) {
    XcdBarrier b; b.bar = bar; b.x = xb_xcc_id(); b.st = st;
    if (threadIdx.x == 0) (void)xb_add(&bar[XB_XCNT(b.x)], 1u);
    return b;
}
__device__ __forceinline__ void xcd_barrier_complete(unsigned* bar, unsigned x, unsigned& nloc, unsigned& nx) {
    const unsigned G = gridDim.x * gridDim.y * gridDim.z;
    unsigned sum, cnt, mine, sp = 0u;
    for (;;) {
        sum = 0u; cnt = 0u; mine = 0u;
#pragma unroll
        for (unsigned j = 0; j < 16; ++j) { const unsigned c = xb_ld(&bar[XB_XCNT(j)]); sum += c; cnt += (c > 0u) ? 1u : 0u; mine = (j == x) ? c : mine; }
        if (sum == G) break;
        __builtin_amdgcn_s_sleep(1);
        if ((++sp & 255u) == 0u) { if (xb_ld(&bar[XB_TMO])) break; if (sp > XB_SPIN_CAP) { atomicAdd(&bar[XB_TMO], 1u); break; } }
    }
    nloc = mine > 0u ? mine : 1u; nx = cnt > 0u ? cnt : 1u;
}
__device__ __forceinline__ void xcd_barrier(const XcdBarrier& b) {
    asm volatile("s_waitcnt vmcnt(0)" ::: "memory");
    __syncthreads();
    if (threadIdx.x == 0) {
        unsigned* bar = b.bar;
        __builtin_amdgcn_s_waitcnt(0);
        unsigned nloc = b.st[0], nx = b.st[1];
        if (nloc == 0u) { xcd_barrier_complete(bar, b.x, nloc, nx); b.st[0] = nloc; b.st[1] = nx; }
        const unsigned old = xb_add(&bar[XB_XSUB(b.x)], 1u);
        const unsigned gen = old / nloc;
        if (old + 1u == (gen + 1u) * nloc) {
            __builtin_amdgcn_fence(__ATOMIC_RELEASE, "agent");
            asm volatile("s_waitcnt vmcnt(0)" ::: "memory");
            const unsigned og = xb_add(&bar[XB_TOP], 1u);
            const unsigned tg = og / nx;
            if (og + 1u == (tg + 1u) * nx) xb_add(&bar[XB_TOPGEN], 1u);
            else XB_SPIN(xb_ld(&bar[XB_TOPGEN]) == tg, bar);
            __builtin_amdgcn_fence(__ATOMIC_ACQUIRE, "agent");
            xb_add(&bar[XB_XGEN(b.x)], 1u);
            asm volatile("s_waitcnt vmcnt(0)" ::: "memory");
        } else {
            XB_SPIN(xb_ld(&bar[XB_XGEN(b.x)]) == gen, bar);
            __builtin_amdgcn_fence(__ATOMIC_ACQUIRE, "agent");
            asm volatile("s_waitcnt vmcnt(0)" ::: "memory");
        }
    }
    __syncthreads();
}

__global__ void __launch_bounds__(256, 2) mega_kernel(Params p) {
  __shared__ __attribute__((aligned(16))) unsigned char lds[LDS_BYTES + 16];
  cg::grid_group grid = cg::this_grid();
  const int nb = gridDim.x, bid = blockIdx.x;
  volatile LAS unsigned* st = (volatile LAS unsigned*)(lds + LDS_BYTES);
  if (threadIdx.x < 4) st[threadIdx.x] = 0u;
  __syncthreads();
  if (p.x == nullptr) grid.sync();
  XcdBarrier xb = xcd_barrier_post(p.bar, st);
  for (int step = 0; step < 20; ++step) {
    const int l = step >= 11 ? 1 : 0;
    const int ph = step < 2 ? step : (step >= 11 ? step - 9 : step);
    int nb_ = nb, bid_ = bid;
    KParams* kp = (KParams*)__builtin_amdgcn_kernarg_segment_ptr();
    asm volatile("" : "+s"(nb_), "+s"(bid_), "+s"(kp));
    run_phase(*kp, ph, l, lds, nb_, bid_);
    if (step < 19) xcd_barrier(xb);
  }
}

extern "C" void kernel_launch(void* const* d_in, const int* in_sizes, int n_in, void* d_out, int out_size, void* d_ws,
                              size_t ws_size, hipStream_t stream) {
  Params p{};
  p.x = (const float*)d_in[0];
  p.c = (const float*)d_in[1];
  p.ada_w = (const float*)d_in[2];
  p.ada_b = (const float*)d_in[3];
  p.pre_mix_g = (const float*)d_in[4];
  p.post_mix_g = (const float*)d_in[5];
  p.w_in = (const float*)d_in[6];
  p.gla_w2 = (const float*)d_in[7];
  p.gla_b = (const float*)d_in[8];
  p.ret_norm_g = (const float*)d_in[9];
  p.gla_norm_g = (const float*)d_in[10];
  p.w_out = (const float*)d_in[11];
  p.pre_ffn_g = (const float*)d_in[12];
  p.post_ffn_g = (const float*)d_in[13];
  p.w_up = (const float*)d_in[14];
  p.conv_w = (const float*)d_in[15];
  p.conv_b = (const float*)d_in[16];
  p.w_down = (const float*)d_in[17];
  p.out = (float*)d_out;
  unsigned char* ws = (unsigned char*)d_ws;
  size_t off = 0;
  p.wt_in = (bf16_t*)(ws + off); off += (size_t)IN_PAD * DM * 2;
  p.wt_out = (bf16_t*)(ws + off); off += (size_t)DM * DM * 2;
  p.wt_up = (bf16_t*)(ws + off); off += (size_t)2 * DFF * DM * 2;
  p.wt_down = (bf16_t*)(ws + off); off += (size_t)DM * DFF * 2;
  p.mod = (float*)(ws + off); off += (size_t)4 * MOD_PLANE * 4;
  p.hn = (bf16_t*)(ws + off); off += (size_t)NTOK * DM * 2;
  const size_t r1 = off;
  p.lq = (bf16_t*)(ws + off); off += (size_t)NTOK * 640 * 2;
  p.lk = (bf16_t*)(ws + off); off += (size_t)NTOK * 640 * 2;
  p.lvt = (bf16_t*)(ws + off); off += (size_t)NTOK * 640 * 2;
  p.lg = (bf16_t*)(ws + off); off += (size_t)NTOK * 640 * 2;
  p.sq = (bf16_t*)(ws + off); off += (size_t)NTOK * 384 * 2;
  p.sk = (bf16_t*)(ws + off); off += (size_t)NTOK * 384 * 2;
  p.svt = (bf16_t*)(ws + off); off += (size_t)NTOK * 384 * 2;
  p.glr = (float*)(ws + off); off += (size_t)NTOK * 16 * 4;
  p.hbuf = (bf16_t*)(ws + r1);
  const size_t r2 = off;
  p.y = (bf16_t*)(ws + r2);
  p.kvt = (float*)(ws + r2);
  p.st = (bf16_t*)(ws + r2 + (size_t)40 * 64 * 4096 * 4);
  p.bl = (float*)(ws + r2 + (size_t)40 * 64 * 4096 * 4 + (size_t)40 * 64 * 4096 * 2);
  off += (size_t)NTOK * DM * 4;
  p.bar = (unsigned*)(ws + off); off += 16384;
  if (off > ws_size) { fprintf(stderr, "workspace too small: need %zu have %zu\n", off, ws_size); return; }

  static int grid_blocks = 0;
  if (!grid_blocks) {
    int dev = 0, cus = 0, per_cu = 0;
    hipGetDevice(&dev);
    hipDeviceGetAttribute(&cus, hipDeviceAttributeMultiprocessorCount, dev);
    hipOccupancyMaxActiveBlocksPerMultiprocessor(&per_cu, mega_kernel, 256, 0);
    if (per_cu > 2) per_cu = 2;
    if (per_cu < 1) per_cu = 1;
    grid_blocks = cus * per_cu;
  }
  (void)hipMemsetAsync(p.bar, 0, 16384, stream);
  void* args[] = {&p};
  hipError_t e = hipLaunchCooperativeKernel((void*)mega_kernel, dim3(grid_blocks), dim3(256), args, 0, stream);
  if (e != hipSuccess) fprintf(stderr, "cooperative launch failed: %s (grid %d)\n", hipGetErrorString(e), grid_blocks);
}
```

```cpp
#include <hip/hip_runtime.h>
#include <hip/hip_cooperative_groups.h>
#include <cstdio>
#include <cstdint>
namespace cg = cooperative_groups;

#ifndef DUPMASK
#define DUPMASK 0
#endif
#ifndef MODE_MULTI
#define MODE_MULTI 0
#endif

typedef unsigned short bf16_t;
typedef short bf16x8 __attribute__((ext_vector_type(8)));
typedef float f32x4 __attribute__((ext_vector_type(4)));
typedef unsigned u32x4 __attribute__((ext_vector_type(4)));
typedef unsigned u32x2 __attribute__((ext_vector_type(2)));

#define NTOK 16384
#define SEQ 4096
#define DM 1024
#define IN_COLS 3728
#define IN_PAD 3840
#define DFF 2816
#define LSTR 72
#define LDS_BYTES 65536
#define EPSF 1e-6f
#define LOG2E 1.4426950408889634f
#define MOD_PLANE (2 * 4 * 6144)

struct Params {
  const float *x, *c, *ada_w, *ada_b, *pre_mix_g, *post_mix_g, *w_in, *gla_w2, *gla_b, *ret_norm_g, *gla_norm_g,
      *w_out, *pre_ffn_g, *post_ffn_g, *w_up, *conv_w, *conv_b, *w_down;
  float* out;
  bf16_t *wt_in, *wt_out, *wt_up, *wt_down;
  float* mod;
  bf16_t* hn;
  bf16_t *lq, *lk, *lvt, *lg, *sq, *sk, *svt;
  float* glr;
  bf16_t* hbuf;
  bf16_t* y;
  float* kvt;
  bf16_t* st;
  float* bl;
  unsigned* bar;
};
typedef const __attribute__((address_space(4))) Params KParams;

__constant__ float ROPE_HI[32] = {1.591549367e-01f, 1.193493679e-01f, 8.949939907e-02f, 6.711508334e-02f, 5.032921210e-02f, 3.774158657e-02f, 2.830219641e-02f, 2.122365311e-02f, 1.591549441e-02f, 1.193493698e-02f, 8.949940093e-03f, 6.711508147e-03f, 5.032921210e-03f, 3.774158424e-03f, 2.830219688e-03f, 2.122365171e-03f, 1.591549488e-03f, 1.193493721e-03f, 8.949940093e-04f, 6.711508031e-04f, 5.032921326e-04f, 3.774158540e-04f, 2.830219455e-04f, 2.122365258e-04f, 1.591549371e-04f, 1.193493736e-04f, 8.949940093e-05f, 6.711508468e-05f, 5.032921035e-05f, 3.774158540e-05f, 2.830219637e-05f, 2.122365186e-05f};
__constant__ float ROPE_LO[32] = {6.420638243e-09f, 2.294664903e-09f, 2.542919653e-09f, -3.316028840e-10f, 5.173299289e-12f, -1.848551645e-09f, -5.826552019e-10f, -3.431038786e-10f, -1.029942243e-10f, 4.320196978e-11f, 6.802745173e-11f, 1.531042237e-10f, 5.173301024e-13f, 4.797548470e-11f, -1.048316434e-10f, 1.053879969e-10f, -5.686555046e-11f, -1.896286773e-11f, 6.802744999e-12f, 2.695195456e-11f, -1.158979943e-11f, -6.843983713e-12f, 1.279990003e-11f, 1.807650600e-12f, 5.954976963e-12f, -3.351478166e-12f, 6.802745216e-13f, -1.670379113e-12f, 1.751403167e-12f, -6.843983930e-13f, -5.389994549e-13f, 9.083608431e-13f};
__constant__ float LOG_GAMMA[6] = {-3.174869716e-02f, -1.574835740e-02f, -7.843177766e-03f, -3.913899418e-03f, -1.955034910e-03f, -9.770396864e-04f};

typedef __bf16 bf16v2 __attribute__((ext_vector_type(2)));
__device__ __forceinline__ unsigned pack2(float a, float b) {
  bf16v2 v;
  v[0] = (__bf16)a;
  v[1] = (__bf16)b;
  return __builtin_bit_cast(unsigned, v);
}
__device__ __forceinline__ bf16_t f2bf(float f) { return (bf16_t)(pack2(f, 0.f) & 0xffffu); }
__device__ __forceinline__ float bf2f(bf16_t h) { return __uint_as_float(((unsigned)h) << 16); }
__device__ __forceinline__ f32x4 mfma16(bf16x8 a, bf16x8 b, f32x4 c) { return __builtin_amdgcn_mfma_f32_16x16x32_bf16(a, b, c, 0, 0, 0); }
__device__ __forceinline__ float fexp2(float x) { return __builtin_amdgcn_exp2f(x); }
__device__ __forceinline__ float flog2(float x) { return __builtin_amdgcn_logf(x); }
__device__ __forceinline__ float siluf(float x) { return x * __builtin_amdgcn_rcpf(1.f + __expf(-x)); }

__device__ __forceinline__ int OTID() { int t = __builtin_amdgcn_workitem_id_x(); asm volatile("" : "+v"(t)); return t; }
__device__ __forceinline__ int UWID(int tid) { return __builtin_amdgcn_readfirstlane(tid >> 6); }

union U4B8 { u32x4 u; bf16x8 v; };
union U2x2B8 { u32x2 u[2]; bf16x8 v; };

struct GTile { const bf16_t* A; const bf16_t* Bt; int lda, ldb, row0, rlo, rhi, col0; };
__device__ __forceinline__ void gemm_issue_tile(const GTile& g, int kt, unsigned char* buf, int wid, int lane) {
  const int lr = lane >> 3, lp = lane & 7;
#pragma unroll
  for (int i = 0; i < 4; ++i) {
    const int q = wid * 4 + i;
    const int r = q * 8 + lr;
    const int c = lp ^ ((r >> 1) & 7);
    int ra = g.row0 + r;
    ra = ra < g.rlo ? g.rlo : (ra > g.rhi ? g.rhi : ra);
    const int lo = __builtin_amdgcn_readfirstlane(q * 1024);
    __builtin_amdgcn_global_load_lds((const unsigned*)(g.A + (size_t)ra * g.lda + c * 8 + kt * 64), (unsigned*)(buf + lo), 16, 0, 0);
    __builtin_amdgcn_global_load_lds((const unsigned*)(g.Bt + (size_t)(g.col0 + r) * g.ldb + c * 8 + kt * 64), (unsigned*)(buf + 16384 + lo), 16, 0, 0);
  }
}
template <bool SWAP>
__device__ __forceinline__ void gemm_mainloop(const GTile& g, const GTile& gn, bool has_next, bool first, int K, unsigned char* base, f32x4 (&acc)[4][4]) {
  const int tid = OTID(), lane = tid & 63, wid = UWID(tid), wr = wid >> 1, wc = wid & 1, fr = lane & 15, fq = lane >> 4;
  const int lr = lane >> 3, lp = lane & 7;
  const bf16_t* ap[4];
  const bf16_t* bp[4];
  int loff[4];
#pragma unroll
  for (int i = 0; i < 4; ++i) {
    const int q = wid * 4 + i;
    const int r = q * 8 + lr;
    const int c = lp ^ ((r >> 1) & 7);
    int ra = g.row0 + r;
    ra = ra < g.rlo ? g.rlo : (ra > g.rhi ? g.rhi : ra);
    ap[i] = g.A + (size_t)ra * g.lda + c * 8;
    bp[i] = g.Bt + (size_t)(g.col0 + r) * g.ldb + c * 8;
    loff[i] = __builtin_amdgcn_readfirstlane(q * 1024);
  }
#pragma unroll
  for (int m = 0; m < 4; ++m)
#pragma unroll
    for (int n = 0; n < 4; ++n) acc[m][n] = (f32x4){0.f, 0.f, 0.f, 0.f};
  int aoff[4], boff[4];
#pragma unroll
  for (int m = 0; m < 4; ++m) { const int R = wr * 64 + m * 16 + fr; aoff[m] = R * 128; }
#pragma unroll
  for (int n = 0; n < 4; ++n) { const int R = wc * 64 + n * 16 + fr; boff[n] = 16384 + R * 128; }
  const int swz = (fr >> 1) & 7;
  const int nk = K >> 6;
#define GEMM_ISSUE(KT, BUFOFF) \
  _Pragma("unroll") for (int i = 0; i < 4; ++i) { \
    __builtin_amdgcn_global_load_lds((const unsigned*)(ap[i] + (KT) * 64), (unsigned*)(base + (BUFOFF) + loff[i]), 16, 0, 0); \
    __builtin_amdgcn_global_load_lds((const unsigned*)(bp[i] + (KT) * 64), (unsigned*)(base + (BUFOFF) + 16384 + loff[i]), 16, 0, 0); }
#define DSR(dst, addr, off) asm volatile("ds_read_b128 %0, %1 offset:%2" : "=v"(dst) : "v"(addr), "n"(off))
#define GEMM_COMPUTE(BUFOFF) \
  { bf16x8 af0[4], bf0[4], af1[4], bf1[4]; \
    DSR(af0[0], adrA0, (BUFOFF)); DSR(af0[1], adrA0, (BUFOFF) + 2048); DSR(af0[2], adrA0, (BUFOFF) + 4096); DSR(af0[3], adrA0, (BUFOFF) + 6144); \
    DSR(bf0[0], adrB0, (BUFOFF) + 16384); DSR(bf0[1], adrB0, (BUFOFF) + 18432); DSR(bf0[2], adrB0, (BUFOFF) + 20480); DSR(bf0[3], adrB0, (BUFOFF) + 22528); \
    DSR(af1[0], adrA1, (BUFOFF)); DSR(af1[1], adrA1, (BUFOFF) + 2048); DSR(af1[2], adrA1, (BUFOFF) + 4096); DSR(af1[3], adrA1, (BUFOFF) + 6144); \
    DSR(bf1[0], adrB1, (BUFOFF) + 16384); DSR(bf1[1], adrB1, (BUFOFF) + 18432); DSR(bf1[2], adrB1, (BUFOFF) + 20480); DSR(bf1[3], adrB1, (BUFOFF) + 22528); \
    asm volatile("s_waitcnt lgkmcnt(8)" : "+v"(af0[0]), "+v"(af0[1]), "+v"(af0[2]), "+v"(af0[3]), "+v"(bf0[0]), "+v"(bf0[1]), "+v"(bf0[2]), "+v"(bf0[3])); \
    __builtin_amdgcn_s_setprio(1); \
    _Pragma("unroll") for (int m = 0; m < 4; ++m) \
      _Pragma("unroll") for (int n = 0; n < 4; ++n) acc[m][n] = SWAP ? mfma16(af0[m], bf0[n], acc[m][n]) : mfma16(bf0[n], af0[m], acc[m][n]); \
    __builtin_amdgcn_sched_barrier(0); \
    asm volatile("s_waitcnt lgkmcnt(0)" : "+v"(af1[0]), "+v"(af1[1]), "+v"(af1[2]), "+v"(af1[3]), "+v"(bf1[0]), "+v"(bf1[1]), "+v"(bf1[2]), "+v"(bf1[3])); \
    __builtin_amdgcn_sched_barrier(0); \
    _Pragma("unroll") for (int m = 0; m < 4; ++m) \
      _Pragma("unroll") for (int n = 0; n < 4; ++n) acc[m][n] = SWAP ? mfma16(af1[m], bf1[n], acc[m][n]) : mfma16(bf1[n], af1[m], acc[m][n]); \
    __builtin_amdgcn_s_setprio(0); }
  const unsigned lbase = (unsigned)(size_t)base;
  const unsigned adrA0 = lbase + (wr * 64 + fr) * 128 + ((0 + fq) ^ swz) * 16, adrA1 = lbase + (wr * 64 + fr) * 128 + ((4 + fq) ^ swz) * 16;
  const unsigned adrB0 = lbase + (wc * 64 + fr) * 128 + ((0 + fq) ^ swz) * 16, adrB1 = lbase + (wc * 64 + fr) * 128 + ((4 + fq) ^ swz) * 16;
  if (first) {
    __syncthreads();
    GEMM_ISSUE(0, 0)
  }
  for (int kt = 0; kt < nk; kt += 2) {
    __syncthreads();
    GEMM_ISSUE(kt + 1, 32768)
    GEMM_COMPUTE(0)
    __syncthreads();
    if (kt + 2 < nk) { GEMM_ISSUE(kt + 2, 0) }
    else if (has_next) gemm_issue_tile(gn, 0, base, wid, lane);
    GEMM_COMPUTE(32768)
  }
}

__device__ __forceinline__ bool tile_map(int t, int MT, int NT, int& mt, int& nt) {
  const int MTm = MT & ~63;
  const int nmain = MTm * NT;
  if (t < nmain) {
    const int x = t & 7, u = t >> 3;
    const int g = u / (8 * NT), rem = u - g * (8 * NT);
    nt = rem >> 3;
    mt = ((g << 3) + (rem & 7)) * 8 + x;
  } else {
    const int r = t - nmain;
    mt = MTm + r / NT;
    nt = r % NT;
  }
  return true;
}
__device__ __forceinline__ int tile_count(int MT, int NT) { return MT * NT; }

__device__ __forceinline__ void store_rows_bf16(bf16_t* buf, int ld, int row0, int colbase, const f32x4 (&acc)[4][4], float scale, bool do_silu) {
  const int lane = OTID() & 63, wid = UWID(OTID()), wr = wid >> 1, fr = lane & 15, fq = lane >> 4;
#pragma unroll
  for (int m = 0; m < 4; ++m) {
    const int row = row0 + wr * 64 + m * 16 + fr;
#pragma unroll
    for (int n = 0; n < 4; ++n) {
      f32x4 v = acc[m][n];
      if (do_silu) { v[0] = siluf(v[0]); v[1] = siluf(v[1]); v[2] = siluf(v[2]); v[3] = siluf(v[3]); }
      u32x2 w;
      w.x = pack2(v[0] * scale, v[1] * scale);
      w.y = pack2(v[2] * scale, v[3] * scale);
      *(u32x2*)(buf + (size_t)row * ld + colbase + n * 16 + fq * 4) = w;
    }
  }
}

__device__ __forceinline__ void rotary_inplace(f32x4 (&acc)[4][4], int row0) {
  const int lane = OTID() & 63, wid = UWID(OTID()), wr = wid >> 1, fr = lane & 15, fq = lane >> 4;
#pragma unroll
  for (int m = 0; m < 4; ++m) {
    const float pos = (float)((row0 + wr * 64 + m * 16 + fr) & (SEQ - 1));
#pragma unroll
    for (int n = 0; n < 2; ++n) {
#pragma unroll
      for (int j = 0; j < 4; ++j) {
        const int i = n * 16 + fq * 4 + j;
        const float fh = ROPE_HI[i], fl = ROPE_LO[i];
        const float ph = pos * fh;
        const float pe = __builtin_fmaf(pos, fh, -ph);
        float rev = (ph - floorf(ph)) + (pe + pos * fl);
        const float sn = __builtin_amdgcn_sinf(rev), cs = __builtin_amdgcn_cosf(rev);
        const float t1 = acc[m][n][j], t2 = acc[m][n + 2][j];
        acc[m][n][j] = t1 * cs - t2 * sn;
        acc[m][n + 2][j] = t1 * sn + t2 * cs;
      }
    }
  }
}

__device__ __forceinline__ void proj_phase(KParams& p, int l, unsigned char* lds, int nb, int bid) {
  const bf16_t* Bt = p.wt_in;
  const int lane = OTID() & 63, wid = UWID(OTID()), wr = wid >> 1, wc = wid & 1, fr = lane & 15, fq = lane >> 4;
  const int NT = IN_PAD / 128;
  const int ntiles = tile_count(NTOK / 128, NT);
  for (int t = bid; t < ntiles; t += nb) {
    int mt, nt, mtn = 0, ntn = 0;
    tile_map(t, NTOK / 128, NT, mt, nt);
    const bool has_next = t + nb < ntiles;
    if (has_next) tile_map(t + nb, NTOK / 128, NT, mtn, ntn);
    const int row0 = mt * 128;
    GTile g, gn;
    g.A = p.hn; g.Bt = Bt; g.lda = DM; g.ldb = DM; g.row0 = row0; g.rlo = 0; g.rhi = NTOK - 1; g.col0 = nt * 128;
    gn = g; gn.row0 = mtn * 128; gn.col0 = ntn * 128;
    const bool vt = (nt >= 6 && nt < 9) || (nt >= 18 && nt < 21) || (nt >= 25 && nt < 27);
    f32x4 acc[4][4];
    if (vt) {
      gemm_mainloop<true>(g, gn, has_next, t == bid, DM, lds, acc);
      bf16_t* dst;
      int head, nh;
      if (nt < 9) { dst = p.lvt; head = (nt - 6) * 2 + wc; nh = 10; }
      else if (nt < 21) { dst = p.svt; head = (nt - 18) * 2 + wc; nh = 6; }
      else { dst = p.lvt; head = 6 + (nt - 25) * 2 + wc; nh = 10; }
      const int b = row0 >> 12;
#pragma unroll
      for (int m = 0; m < 4; ++m) {
        const int pos = ((row0 + wr * 64 + m * 16 + fq * 4) & (SEQ - 1));
#pragma unroll
        for (int n = 0; n < 4; ++n) {
          const int e = n * 16 + fr;
          u32x2 w;
          w.x = pack2(acc[m][n][0], acc[m][n][1]);
          w.y = pack2(acc[m][n][2], acc[m][n][3]);
          *(u32x2*)(dst + ((size_t)(b * nh + head) * 64 + e) * SEQ + pos) = w;
        }
      }
    } else {
      gemm_mainloop<false>(g, gn, has_next, t == bid, DM, lds, acc);
      if (nt < 3) { rotary_inplace(acc, row0); store_rows_bf16(p.lq, 640, row0, nt * 128 + wc * 64, acc, 0.125f, false); }
      else if (nt < 6) { rotary_inplace(acc, row0); store_rows_bf16(p.lk, 640, row0, (nt - 3) * 128 + wc * 64, acc, 1.f, false); }
      else if (nt < 12) { store_rows_bf16(p.lg, 640, row0, (nt - 9) * 128 + wc * 64, acc, 1.f, true); }
      else if (nt < 15) { store_rows_bf16(p.sq, 384, row0, (nt - 12) * 128 + wc * 64, acc, 0.125f * LOG2E, false); }
      else if (nt < 18) { store_rows_bf16(p.sk, 384, row0, (nt - 15) * 128 + wc * 64, acc, 1.f, false); }
      else if (nt < 23) { store_rows_bf16(p.lq, 640, row0, 384 + (nt - 21) * 128 + wc * 64, acc, 0.125f, false); }
      else if (nt < 25) { store_rows_bf16(p.lk, 640, row0, 384 + (nt - 23) * 128 + wc * 64, acc, 1.f, false); }
      else if (nt < 29) { store_rows_bf16(p.lg, 640, row0, 384 + (nt - 27) * 128 + wc * 64, acc, 1.f, true); }
      else {
        if (wc == 0) {
#pragma unroll
          for (int m = 0; m < 4; ++m) {
            const int row = row0 + wr * 64 + m * 16 + fr;
            *(f32x4*)(p.glr + (size_t)row * 16 + fq * 4) = acc[m][0];
          }
        }
      }
    }
  }
}

__device__ __forceinline__ void gemm_y_phase(KParams& p, const bf16_t* A, int K, const bf16_t* Bt, unsigned char* lds, int nb, int bid) {
  const int lane = OTID() & 63, wid = UWID(OTID()), wr = wid >> 1, wc = wid & 1, fr = lane & 15, fq = lane >> 4;
  const int NT = DM / 128;
  const int ntiles = tile_count(NTOK / 128, NT);
  for (int t = bid; t < ntiles; t += nb) {
    int mt, nt, mtn = 0, ntn = 0;
    tile_map(t, NTOK / 128, NT, mt, nt);
    const bool has_next = t + nb < ntiles;
    if (has_next) tile_map(t + nb, NTOK / 128, NT, mtn, ntn);
    const int row0 = mt * 128;
    GTile g, gn;
    g.A = A; g.Bt = Bt; g.lda = K; g.ldb = K; g.row0 = row0; g.rlo = 0; g.rhi = NTOK - 1; g.col0 = nt * 128;
    gn = g; gn.row0 = mtn * 128; gn.col0 = ntn * 128;
    f32x4 acc[4][4];
    gemm_mainloop<false>(g, gn, has_next, t == bid, K, lds, acc);
#pragma unroll
    for (int m = 0; m < 4; ++m) {
      const int row = row0 + wr * 64 + m * 16 + fr;
#pragma unroll
      for (int n = 0; n < 4; ++n) {
        u32x2 w;
        w.x = pack2(acc[m][n][0], acc[m][n][1]);
        w.y = pack2(acc[m][n][2], acc[m][n][3]);
        *(u32x2*)(p.y + (size_t)row * DM + nt * 128 + wc * 64 + n * 16 + fq * 4) = w;
      }
    }
  }
}

__device__ __forceinline__ void up_phase(KParams& p, int l, unsigned char* lds, int nb, int bid) {
  unsigned char* sAct = lds + 32768;
  const int lane = OTID() & 63, wid = UWID(OTID()), wr = wid >> 1, wc = wid & 1, fr = lane & 15, fq = lane >> 4;
  const int NT = DFF / 64;
  const int MT = 4 * 33;
  const int ntiles = tile_count(MT, NT);
  const float* cw = p.conv_w + (size_t)l * 3 * DFF;
  const float* cb = p.conv_b + (size_t)l * DFF;
  for (int t = bid; t < ntiles; t += nb) {
    int mt, nt, mtn = 0, ntn = 0;
    tile_map(t, MT, NT, mt, nt);
    const bool has_next = t + nb < ntiles;
    if (has_next) tile_map(t + nb, MT, NT, mtn, ntn);
    const int b = mt / 33, it = mt % 33;
    const int p0 = it * 126;
    const int row0 = b * SEQ + p0 - 2;
    GTile g, gn;
    g.A = p.hn; g.Bt = p.wt_up; g.lda = DM; g.ldb = DM; g.row0 = row0; g.rlo = b * SEQ; g.rhi = b * SEQ + SEQ - 1; g.col0 = nt * 128;
    {
      const int bn = mtn / 33, itn = mtn % 33;
      gn = g; gn.row0 = bn * SEQ + itn * 126 - 2; gn.rlo = bn * SEQ; gn.rhi = bn * SEQ + SEQ - 1; gn.col0 = ntn * 128;
    }
    f32x4 cw0[2], cw1[2], cw2[2], cbb[2];
#pragma unroll
    for (int n = 0; n < 2; ++n) {
      const int fc = nt * 64 + (wc * 8 + n * 4 + fq) * 4;
      cw0[n] = *(const f32x4*)(cw + fc); cw1[n] = *(const f32x4*)(cw + DFF + fc); cw2[n] = *(const f32x4*)(cw + 2 * DFF + fc);
      cbb[n] = *(const f32x4*)(cb + fc);
    }
    f32x4 acc[4][4];
    gemm_mainloop<false>(g, gn, has_next, t == bid, DM, lds, acc);
    asm volatile("s_waitcnt lgkmcnt(0)" ::: "memory");
    __builtin_amdgcn_s_barrier();
    asm volatile("" ::: "memory");
#pragma unroll
    for (int m = 0; m < 4; ++m)
#pragma unroll
      for (int n = 0; n < 2; ++n) {
        const int r = wr * 64 + m * 16 + fr;
        const int c16 = wc * 8 + n * 4 + fq;
        *(f32x4*)(sAct + r * 256 + ((c16 ^ (r & 15)) << 4)) = acc[m][n];
      }
    asm volatile("s_waitcnt lgkmcnt(0)" ::: "memory");
    __builtin_amdgcn_s_barrier();
    asm volatile("" ::: "memory");
#pragma unroll
    for (int n = 0; n < 2; ++n) {
      const int c16 = wc * 8 + n * 4 + fq;
      const int fc = nt * 64 + c16 * 4;
      const f32x4 w0 = cw0[n], w1 = cw1[n], w2 = cw2[n];
      const f32x4 bb = cbb[n];
#pragma unroll
      for (int m = 0; m < 4; ++m) {
        const int r = wr * 64 + m * 16 + fr;
        const int pos = p0 - 2 + r;
        if (r >= 2 && pos < SEQ) {
          const f32x4 a0 = acc[m][n];
          f32x4 a1 = *(const f32x4*)(sAct + (r - 1) * 256 + ((c16 ^ ((r - 1) & 15)) << 4));
          f32x4 a2 = *(const f32x4*)(sAct + (r - 2) * 256 + ((c16 ^ ((r - 2) & 15)) << 4));
          if (pos < 1) a1 = (f32x4){0.f, 0.f, 0.f, 0.f};
          if (pos < 2) a2 = (f32x4){0.f, 0.f, 0.f, 0.f};
          float hv[4];
#pragma unroll
          for (int j = 0; j < 4; ++j) {
            const float xv = w2[j] * a0[j] + w1[j] * a1[j] + w0[j] * a2[j] + bb[j];
            const float u = 0.7978845608028654f * (xv + 0.044715f * xv * xv * xv);
            const float gl = xv * __builtin_amdgcn_rcpf(1.f + fexp2(-2.f * LOG2E * u));
            hv[j] = gl * acc[m][n + 2][j];
          }
          u32x2 w;
          w.x = pack2(hv[0], hv[1]);
          w.y = pack2(hv[2], hv[3]);
          *(u32x2*)(p.hbuf + (size_t)(b * SEQ + pos) * DFF + fc) = w;
        }
      }
    }
  }
}

__device__ __forceinline__ float wave_sum(float v) {
#pragma unroll
  for (int o = 32; o > 0; o >>= 1) v += __shfl_xor(v, o);
  return v;
}
__device__ __forceinline__ f32x4 ld_mod4(const float* ptr) {
  return ((*(const f32x4*)ptr + *(const f32x4*)(ptr + MOD_PLANE)) + *(const f32x4*)(ptr + 2 * MOD_PLANE)) + *(const f32x4*)(ptr + 3 * MOD_PLANE);
}
__device__ __forceinline__ void rowpass_phase(const float* xsrc, const bf16_t* y, const float* gate, const float* postg, float* xdst,
                              const float* preg, const float* sc, const float* sh, bf16_t* hn, int nb, int bid) {
  const int lane = OTID() & 63, wid = UWID(OTID());
  const int rpw = (NTOK + nb * 4 - 1) / (nb * 4);
  const int rbeg = (bid * 4 + wid) * rpw;
  if (rbeg >= NTOK) return;
  const int rend = rbeg + rpw < NTOK ? rbeg + rpw : NTOK;
  const int b = rbeg >> 12;
  f32x4 vg[4], vpg[4], vpre[4], vsc[4], vsh[4];
#pragma unroll
  for (int i = 0; i < 4; ++i) {
    const int col = i * 256 + lane * 4;
    if (y) { vg[i] = ld_mod4(gate + b * 6144 + col); vpg[i] = *(const f32x4*)(postg + col); }
    if (hn) { vpre[i] = *(const f32x4*)(preg + col); vsc[i] = ld_mod4(sc + b * 6144 + col) + 1.f; vsh[i] = ld_mod4(sh + b * 6144 + col); }
  }
  for (int row0 = rbeg; row0 < rend; row0 += 2) {
    f32x4 xv[2][4];
    u32x2 yr[2][4];
#pragma unroll
    for (int rr = 0; rr < 2; ++rr) {
      const int row = row0 + rr;
      if (row < rend) {
#pragma unroll
        for (int i = 0; i < 4; ++i) xv[rr][i] = __builtin_nontemporal_load((const f32x4*)(xsrc + (size_t)row * DM + i * 256 + lane * 4));
        if (y) {
#pragma unroll
          for (int i = 0; i < 4; ++i) yr[rr][i] = __builtin_nontemporal_load((const u32x2*)(y + (size_t)row * DM + i * 256 + lane * 4));
        }
      }
    }
#pragma unroll
    for (int rr = 0; rr < 2; ++rr) {
      const int row = row0 + rr;
      if (row < rend) {
        if (y) {
          f32x4 yv[4];
          float ss = 0.f;
#pragma unroll
          for (int i = 0; i < 4; ++i) {
            yv[i][0] = __uint_as_float(yr[rr][i].x << 16);
            yv[i][1] = __uint_as_float(yr[rr][i].x & 0xffff0000u);
            yv[i][2] = __uint_as_float(yr[rr][i].y << 16);
            yv[i][3] = __uint_as_float(yr[rr][i].y & 0xffff0000u);
            ss += yv[i][0] * yv[i][0] + yv[i][1] * yv[i][1] + yv[i][2] * yv[i][2] + yv[i][3] * yv[i][3];
          }
          ss = wave_sum(ss);
          const float r = rsqrtf(ss * (1.f / DM) + EPSF);
#pragma unroll
          for (int i = 0; i < 4; ++i) {
            xv[rr][i] = xv[rr][i] + vg[i] * (yv[i] * r) * vpg[i];
            __builtin_nontemporal_store(xv[rr][i], (f32x4*)(xdst + (size_t)row * DM + i * 256 + lane * 4));
          }
        }
        if (hn) {
          float ss = 0.f;
#pragma unroll
          for (int i = 0; i < 4; ++i) ss += xv[rr][i][0] * xv[rr][i][0] + xv[rr][i][1] * xv[rr][i][1] + xv[rr][i][2] * xv[rr][i][2] + xv[rr][i][3] * xv[rr][i][3];
          ss = wave_sum(ss);
          const float r = rsqrtf(ss * (1.f / DM) + EPSF);
#pragma unroll
          for (int i = 0; i < 4; ++i) {
            f32x4 h = (xv[rr][i] * r) * vpre[i] * vsc[i] + vsh[i];
            u32x2 w;
            w.x = pack2(h[0], h[1]);
            w.y = pack2(h[2], h[3]);
            *(u32x2*)(hn + (size_t)row * DM + i * 256 + lane * 4) = w;
          }
        }
      }
    }
  }
}

struct CvtDesc { const float* src; bf16_t* dst; int N, K, k0, ndst0, nsA, nsB; };
__device__ __forceinline__ CvtDesc cvt_decode(KParams& p, int l, int it) {
  const int n_in = 16 * 60, n_out = 16 * 16, n_up = 16 * 88;
  CvtDesc d;
  int i = it;
  if (i < n_in) {
    const int kt = i % 16, ntile = i / 16, ns = ntile * 64;
    d.src = p.w_in + (size_t)l * DM * IN_COLS; d.dst = p.wt_in; d.N = IN_COLS; d.K = DM; d.k0 = kt * 64; d.ndst0 = ns;
    d.nsA = ns < IN_COLS ? ns : -1; d.nsB = ns + 32 < IN_COLS ? ns + 32 : -1;
    return d;
  }
  i -= n_in;
  if (i < n_out) {
    const int kt = i % 16, ntile = i / 16;
    d.src = p.w_out + (size_t)l * DM * DM; d.dst = p.wt_out; d.N = DM; d.K = DM; d.k0 = kt * 64; d.ndst0 = ntile * 64; d.nsA = ntile * 64; d.nsB = ntile * 64 + 32;
    return d;
  }
  i -= n_out;
  if (i < n_up) {
    const int kt = i % 16, q = i / 16;
    const int j = q >> 1, wcv = q & 1;
    d.src = p.w_up + (size_t)l * DM * 2 * DFF; d.dst = p.wt_up; d.N = 2 * DFF; d.K = DM; d.k0 = kt * 64; d.ndst0 = q * 64;
    d.nsA = j * 64 + wcv * 32; d.nsB = DFF + j * 64 + wcv * 32;
    return d;
  }
  i -= n_up;
  {
    const int kt = i % 44, ntile = i / 44;
    d.src = p.w_down + (size_t)l * DFF * DM; d.dst = p.wt_down; d.N = DM; d.K = DFF; d.k0 = kt * 64; d.ndst0 = ntile * 64; d.nsA = ntile * 64; d.nsB = ntile * 64 + 32;
    return d;
  }
}
__device__ __forceinline__ void cvt_load(const CvtDesc& d, int tid, f32x4 (&v)[4]) {
  const int c4 = (tid & 15) * 4, r = tid >> 4;
  const int ns = c4 < 32 ? d.nsA : d.nsB;
  const int sc = ns + (c4 & 31);
  const bool ok = ns >= 0 && sc < d.N;
#pragma unroll
  for (int ps = 0; ps < 4; ++ps) {
    v[ps] = (f32x4){0.f, 0.f, 0.f, 0.f};
    if (ok) v[ps] = __builtin_nontemporal_load((const f32x4*)(d.src + (size_t)(d.k0 + r + 16 * ps) * d.N + sc));
  }
}

__device__ __forceinline__ void convert_weights_phase(KParams& p, int l, unsigned char* lds, int stride, int first, int lo, int hi) {
  float* tiles = (float*)lds;
  const int total = hi;
  const int tid = OTID();
  const int nb = stride, bid = lo + first;
  if (first < 0 || bid >= total) return;
  CvtDesc cur = cvt_decode(p, l, bid);
  f32x4 v[4];
  cvt_load(cur, tid, v);
  int par = 0;
  __syncthreads();
  for (int it = bid; it < total; it += nb) {
    float* tile = tiles + par * (64 * 65);
    {
      const int c4 = (tid & 15) * 4, r = tid >> 4;
#pragma unroll
      for (int ps = 0; ps < 4; ++ps) {
        const int k = r + 16 * ps;
        tile[k * 65 + c4 + 0] = v[ps][0];
        tile[k * 65 + c4 + 1] = v[ps][1];
        tile[k * 65 + c4 + 2] = v[ps][2];
        tile[k * 65 + c4 + 3] = v[ps][3];
      }
    }
    __syncthreads();
    const CvtDesc me = cur;
    if (it + nb < total) { cur = cvt_decode(p, l, it + nb); cvt_load(cur, tid, v); }
    {
      const int n = tid >> 2, kc = (tid & 3) * 16;
      unsigned w[8];
#pragma unroll
      for (int i = 0; i < 8; ++i) w[i] = pack2(tile[(kc + 2 * i) * 65 + n], tile[(kc + 2 * i + 1) * 65 + n]);
      u32x4* dd = (u32x4*)(me.dst + (size_t)(me.ndst0 + n) * me.K + me.k0 + kc);
      dd[0] = (u32x4){w[0], w[1], w[2], w[3]};
      dd[1] = (u32x4){w[4], w[5], w[6], w[7]};
    }
    par ^= 1;
  }
  __syncthreads();
}

__device__ __forceinline__ void mod_phase(KParams& p, unsigned char* lds, int nb, int bid) {
  float* sc_ = (float*)lds;
  float* red = sc_ + 4096;
  const int tid = OTID(), lane = tid & 63, wid = UWID(tid);
  for (int it = bid; it < 192; it += nb) {
    const int l = it / 96, rem = it % 96, cc = (rem >> 2) * 256, kq = rem & 3;
    __syncthreads();
    {
      f32x4 cv[4];
#pragma unroll
      for (int j = 0; j < 4; ++j) cv[j] = *(const f32x4*)(p.c + tid * 16 + j * 4);
#pragma unroll
      for (int j = 0; j < 4; ++j) {
        f32x4 r;
        r[0] = siluf(cv[j][0]); r[1] = siluf(cv[j][1]); r[2] = siluf(cv[j][2]); r[3] = siluf(cv[j][3]);
        *(f32x4*)(sc_ + tid * 16 + j * 4) = r;
      }
    }
    __syncthreads();
    const float* w = p.ada_w + (size_t)l * DM * 6144 + cc + lane * 4;
    f32x4 a0 = (f32x4){0.f, 0.f, 0.f, 0.f}, a1 = a0, a2 = a0, a3 = a0;
    const int kb = kq * 256 + wid * 64;
#pragma unroll 32
    for (int k = kb; k < kb + 64; ++k) {
      const f32x4 wv = __builtin_nontemporal_load((const f32x4*)(w + (size_t)k * 6144));
      a0 += wv * sc_[k];
      a1 += wv * sc_[1024 + k];
      a2 += wv * sc_[2048 + k];
      a3 += wv * sc_[3072 + k];
    }
    *(f32x4*)(red + (wid * 4 + 0) * 256 + lane * 4) = a0;
    *(f32x4*)(red + (wid * 4 + 1) * 256 + lane * 4) = a1;
    *(f32x4*)(red + (wid * 4 + 2) * 256 + lane * 4) = a2;
    *(f32x4*)(red + (wid * 4 + 3) * 256 + lane * 4) = a3;
    __syncthreads();
    {
      const int b = wid;
      f32x4 sv = (*(const f32x4*)(red + (0 * 4 + b) * 256 + lane * 4) + *(const f32x4*)(red + (1 * 4 + b) * 256 + lane * 4)) +
                 (*(const f32x4*)(red + (2 * 4 + b) * 256 + lane * 4) + *(const f32x4*)(red + (3 * 4 + b) * 256 + lane * 4));
      if (kq == 0) sv += *(const f32x4*)(p.ada_b + (size_t)l * 6144 + cc + lane * 4);
      *(f32x4*)(p.mod + (size_t)kq * MOD_PLANE + (size_t)(l * 4 + b) * 6144 + cc + lane * 4) = sv;
    }
  }
}

__device__ __forceinline__ void sb_item(KParams& p, int b, int h, int qt, unsigned char* lds) {
  bf16_t* sK = (bf16_t*)lds;
  bf16_t* sV = sK + 64 * LSTR;
  volatile int* sFlag = (volatile int*)(sV + 64 * LSTR);
  const int tid = OTID(), lane = tid & 63, wid = UWID(tid), fr = lane & 15, fq = lane >> 4;
  const int sr = tid >> 3, sc8 = (tid & 7) * 8;
  const size_t tokq = (size_t)b * SEQ + qt * 64 + wid * 16 + fr;
  bf16x8 qf[2];
#pragma unroll
  for (int ks = 0; ks < 2; ++ks) qf[ks] = *(const bf16x8*)(p.sq + tokq * 384 + h * 64 + ks * 32 + fq * 8);
  f32x4 o[4];
#pragma unroll
  for (int n = 0; n < 4; ++n) o[n] = (f32x4){0.f, 0.f, 0.f, 0.f};
  float carry = 0.f;
  const int tq = qt * 64 + wid * 16 + fr;
  const bf16_t* kbase = p.sk + ((size_t)b * SEQ) * 384 + h * 64 + sc8;
  const bf16_t* vbase = p.svt + ((size_t)(b * 6 + h) * 64) * SEQ + sc8;
  u32x4 kreg[2], vreg[2];
#pragma unroll
  for (int i = 0; i < 2; ++i) {
    kreg[i] = *(const u32x4*)(kbase + (size_t)(qt * 64 + sr + 32 * i) * 384);
    vreg[i] = *(const u32x4*)(vbase + (size_t)(sr + 32 * i) * SEQ + qt * 64);
  }
  __syncthreads();
  for (int kt = qt; kt >= 0; --kt) {
#pragma unroll
    for (int i = 0; i < 2; ++i) {
      *(u32x4*)(sK + (sr + 32 * i) * LSTR + sc8) = kreg[i];
      *(u32x4*)(sV + (sr + 32 * i) * LSTR + sc8) = vreg[i];
    }
    __syncthreads();
    if (kt > 0) {
#pragma unroll
      for (int i = 0; i < 2; ++i) {
        kreg[i] = *(const u32x4*)(kbase + (size_t)((kt - 1) * 64 + sr + 32 * i) * 384);
        vreg[i] = *(const u32x4*)(vbase + (size_t)(sr + 32 * i) * SEQ + (kt - 1) * 64);
      }
    }
    f32x4 z[4];
#pragma unroll
    for (int m = 0; m < 4; ++m) {
      z[m] = (f32x4){0.f, 0.f, 0.f, 0.f};
#pragma unroll
      for (int ks = 0; ks < 2; ++ks) {
        const bf16x8 kf = *(const bf16x8*)(sK + (m * 16 + fr) * LSTR + ks * 32 + fq * 8);
        z[m] = mfma16(kf, qf[ks], z[m]);
      }
    }
    float lk[4][4], lb[4][4];
    const bool diag = (kt == qt);
#pragma unroll
    for (int m = 0; m < 4; ++m)
#pragma unroll
      for (int j = 0; j < 4; ++j) {
        const float zz = z[m][j];
        const float sp = fmaxf(zz, 0.f) + flog2(1.f + fexp2(-fabsf(zz)));
        const int s = kt * 64 + m * 16 + fq * 4 + j;
        const bool valid = (!diag) || (s < tq);
        lk[m][j] = valid ? -sp : 0.f;
        lb[m][j] = valid ? (zz - sp) : -1e30f;
      }
    float tot[4], ex[4];
#pragma unroll
    for (int m = 0; m < 4; ++m) {
      const float s4 = (lk[m][0] + lk[m][1]) + (lk[m][2] + lk[m][3]);
      const float bb = __shfl_xor(s4, 16);
      const float cc = s4 + bb;
      const float dd = __shfl_xor(cc, 32);
      tot[m] = cc + dd;
      ex[m] = ((fq & 1) ? 0.f : bb) + ((fq & 2) ? 0.f : dd);
    }
    float a[4][4];
    float base = carry;
#pragma unroll
    for (int m = 3; m >= 0; --m) {
      float run = base + ex[m];
#pragma unroll
      for (int j = 3; j >= 0; --j) {
        a[m][j] = fexp2(lb[m][j] + run);
        run += lk[m][j];
      }
      base += tot[m];
    }
    carry = base;
#pragma unroll
    for (int u = 0; u < 2; ++u) {
      U4B8 pa;
      pa.u.x = pack2(a[2 * u][0], a[2 * u][1]);
      pa.u.y = pack2(a[2 * u][2], a[2 * u][3]);
      pa.u.z = pack2(a[2 * u + 1][0], a[2 * u + 1][1]);
      pa.u.w = pack2(a[2 * u + 1][2], a[2 * u + 1][3]);
#pragma unroll
      for (int n = 0; n < 4; ++n) {
        U2x2B8 vf;
        vf.u[0] = *(const u32x2*)(sV + (n * 16 + fr) * LSTR + u * 32 + fq * 4);
        vf.u[1] = *(const u32x2*)(sV + (n * 16 + fr) * LSTR + u * 32 + 16 + fq * 4);
        o[n] = mfma16(pa.v, vf.v, o[n]);
      }
    }
    {
      const int wdone = __all(carry < -180.f) ? 1 : 0;
      if (lane == 0) sFlag[wid] = wdone;
      __syncthreads();
      if (sFlag[0] & sFlag[1] & sFlag[2] & sFlag[3]) break;
    }
  }
  bf16_t* ob = p.hn + ((size_t)b * SEQ + qt * 64 + wid * 16) * DM + 384 + h * 64;
#pragma unroll
  for (int n = 0; n < 4; ++n)
#pragma unroll
    for (int j = 0; j < 4; ++j) ob[(size_t)(fq * 4 + j) * DM + n * 16 + fr] = f2bf(o[n][j]);
}

__device__ __forceinline__ void lin_prep(KParams& p, int l, int b, int g, int ic, float (&bc)[16], float& blast, float* sGlr, float* sTot) {
  const int tid = OTID(), lane = tid & 63, wid = UWID(tid);
  if (g < 6) {
    const float lg = LOG_GAMMA[g];
#pragma unroll
    for (int r = 0; r < 16; ++r) bc[r] = (float)(16 * wid + r + 1) * lg;
    blast = 64.f * lg;
  } else {
    const size_t T0 = (size_t)b * SEQ + ic * 64;
    *(f32x4*)(sGlr + tid * 4) = *(const f32x4*)(p.glr + T0 * 16 + tid * 4);
    const int c = (g - 6) * 64 + lane;
    float w2r[16];
#pragma unroll
    for (int rr = 0; rr < 16; ++rr) w2r[rr] = p.gla_w2[((size_t)l * 16 + rr) * 256 + c];
    const float gb = p.gla_b[(size_t)l * 256 + c];
    __syncthreads();
    float run = 0.f;
#pragma unroll
    for (int r = 0; r < 16; ++r) {
      const int t = 16 * wid + r;
      float xv = gb;
#pragma unroll
      for (int rr = 0; rr < 16; ++rr) xv += sGlr[t * 16 + rr] * w2r[rr];
      const float ls = -(fmaxf(-xv, 0.f) + __logf(1.f + __expf(-fabsf(xv))));
      run += ls * (1.f / 16.f);
      bc[r] = run;
    }
    sTot[wid * 64 + lane] = run;
    __syncthreads();
    float off = 0.f, tt = 0.f;
#pragma unroll
    for (int w = 0; w < 4; ++w) {
      const float v = sTot[w * 64 + lane];
      tt += v;
      if (w < wid) off += v;
    }
#pragma unroll
    for (int r = 0; r < 16; ++r) bc[r] += off;
    blast = tt;
  }
}

__device__ __forceinline__ void lin_kv_item(KParams& p, int l, int b, int g, int ic, unsigned char* lds) {
  bf16_t* sKT = (bf16_t*)lds;
  bf16_t* sV = sKT + 64 * LSTR;
  float* sGlr = (float*)(sV + 64 * LSTR);
  float* sTot = sGlr + 1024;
  const int tid = OTID(), lane = tid & 63, wid = UWID(tid), fr = lane & 15, fq = lane >> 4;
  const int bg = b * 10 + g;
  const size_t T0 = (size_t)b * SEQ + ic * 64;
  __syncthreads();
  bf16_t kraw[16];
  u32x4 vreg[2];
  {
#pragma unroll
    for (int r = 0; r < 16; ++r) kraw[r] = p.lk[(T0 + 16 * wid + r) * 640 + g * 64 + lane];
    const int sr = tid >> 3, sc8 = (tid & 7) * 8;
#pragma unroll
    for (int i = 0; i < 2; ++i) vreg[i] = *(const u32x4*)(p.lvt + ((size_t)bg * 64 + sr + 32 * i) * SEQ + ic * 64 + sc8);
  }
  float bc[16], blast;
  lin_prep(p, l, b, g, ic, bc, blast, sGlr, sTot);
  {
    unsigned w[8];
#pragma unroll
    for (int r = 0; r < 16; r += 2) {
      const float k0 = bf2f(kraw[r]);
      const float k1 = bf2f(kraw[r + 1]);
      w[r >> 1] = pack2(k0 * __expf(blast - bc[r]), k1 * __expf(blast - bc[r + 1]));
    }
    u32x4* d = (u32x4*)(sKT + lane * LSTR + 16 * wid);
    d[0] = (u32x4){w[0], w[1], w[2], w[3]};
    d[1] = (u32x4){w[4], w[5], w[6], w[7]};
  }
  {
    const int sr = tid >> 3, sc8 = (tid & 7) * 8;
#pragma unroll
    for (int i = 0; i < 2; ++i) *(u32x4*)(sV + (sr + 32 * i) * LSTR + sc8) = vreg[i];
  }
  __syncthreads();
  float* kvo = p.kvt + ((size_t)bg * 64 + ic) * 4096;
#pragma unroll
  for (int ne = 0; ne < 4; ++ne) {
    f32x4 acc = (f32x4){0.f, 0.f, 0.f, 0.f};
#pragma unroll
    for (int ks = 0; ks < 2; ++ks) {
      const bf16x8 af = *(const bf16x8*)(sKT + (wid * 16 + fr) * LSTR + ks * 32 + fq * 8);
      const bf16x8 bf = *(const bf16x8*)(sV + (ne * 16 + fr) * LSTR + ks * 32 + fq * 8);
      acc = mfma16(af, bf, acc);
    }
    __builtin_nontemporal_store(acc, (f32x4*)(kvo + (ne * 16 + fr) * 64 + wid * 16 + fq * 4));
  }
  if (wid == 0) p.bl[((size_t)bg * 64 + ic) * 64 + lane] = blast;
}

__device__ __forceinline__ void lin_scan_phase(KParams& p, int nb, int bid) {
  const int tid = OTID();
  const int total = 40 * 4096;
  const int per = (total + nb - 1) / nb;
  const int lo = bid * per, hi = lo + per < total ? lo + per : total;
  for (int base = lo; base < hi; base += 512) {
    const int e0 = base + tid, e1 = base + 256 + tid;
    const bool a0 = e0 < hi, a1 = e1 < hi;
    const int ee0 = a0 ? e0 : lo, ee1 = a1 ? e1 : lo;
    const int bg0 = ee0 >> 12, bg1 = ee1 >> 12;
    const int i0x = ee0 & 4095, i1x = ee1 & 4095;
    const float* kv0 = p.kvt + (size_t)bg0 * 64 * 4096 + i0x;
    const float* kv1 = p.kvt + (size_t)bg1 * 64 * 4096 + i1x;
    const float* bl0 = p.bl + (size_t)bg0 * 64 * 64 + (i0x & 63);
    const float* bl1 = p.bl + (size_t)bg1 * 64 * 64 + (i1x & 63);
    bf16_t* so0 = p.st + (size_t)bg0 * 64 * 4096 + i0x;
    bf16_t* so1 = p.st + (size_t)bg1 * 64 * 4096 + i1x;
    float s0 = 0.f, s1 = 0.f;
#pragma nounroll
    for (int c0 = 0; c0 < 64; c0 += 16) {
      float kva[16], da[16], kvb[16], db[16];
#pragma unroll
      for (int i = 0; i < 16; ++i) {
        kva[i] = __builtin_nontemporal_load(kv0 + (size_t)(c0 + i) * 4096);
        da[i] = bl0[(c0 + i) * 64];
      }
      if (a1) {
#pragma unroll
        for (int i = 0; i < 16; ++i) {
          kvb[i] = __builtin_nontemporal_load(kv1 + (size_t)(c0 + i) * 4096);
          db[i] = bl1[(c0 + i) * 64];
        }
      }
      if (a0) {
#pragma unroll
        for (int i = 0; i < 16; ++i) {
          so0[(size_t)(c0 + i) * 4096] = f2bf(s0);
          s0 = __expf(da[i]) * s0 + kva[i];
        }
      }
      if (a1) {
#pragma unroll
        for (int i = 0; i < 16; ++i) {
          so1[(size_t)(c0 + i) * 4096] = f2bf(s1);
          s1 = __expf(db[i]) * s1 + kvb[i];
        }
      }
    }
  }
}

__device__ __forceinline__ void lin_out_item(KParams& p, int l, int b, int g, int ic, unsigned char* lds) {
  bf16_t* sQp = (bf16_t*)lds;
  bf16_t* sQm = sQp + 64 * LSTR;
  bf16_t* sKp = sQm + 64 * LSTR;
  bf16_t* sKm = sKp + 64 * LSTR;
  bf16_t* sV = sKm + 64 * LSTR;
  bf16_t* sS = sV + 64 * LSTR;
  float* sGlr = (float*)(sS + 64 * LSTR);
  float* sTot = sGlr + 1024;
  const int tid = OTID(), lane = tid & 63, wid = UWID(tid), fr = lane & 15, fq = lane >> 4;
  const int bg = b * 10 + g;
  const size_t T0 = (size_t)b * SEQ + ic * 64;
  __syncthreads();
  bf16_t qraw[16], kraw[16];
  u32x4 vreg[2], sreg[2];
  {
#pragma unroll
    for (int r = 0; r < 16; ++r) {
      qraw[r] = p.lq[(T0 + 16 * wid + r) * 640 + g * 64 + lane];
      kraw[r] = p.lk[(T0 + 16 * wid + r) * 640 + g * 64 + lane];
    }
    const int sr = tid >> 3, sc8 = (tid & 7) * 8;
#pragma unroll
    for (int i = 0; i < 2; ++i) {
      vreg[i] = *(const u32x4*)(p.lvt + ((size_t)bg * 64 + sr + 32 * i) * SEQ + ic * 64 + sc8);
      sreg[i] = __builtin_nontemporal_load((const u32x4*)(p.st + ((size_t)bg * 64 + ic) * 4096 + (sr + 32 * i) * 64 + sc8));
    }
  }
  bf16_t graw[4][4];
  float gamv[4];
  {
    const float* gam0 = (g < 6) ? (p.ret_norm_g + (size_t)l * 384 + g * 64) : (p.gla_norm_g + (size_t)l * 256 + (g - 6) * 64);
#pragma unroll
    for (int ne = 0; ne < 4; ++ne) {
      gamv[ne] = gam0[ne * 16 + fr];
#pragma unroll
      for (int j = 0; j < 4; ++j) graw[j][ne] = p.lg[(T0 + wid * 16 + fq * 4 + j) * 640 + g * 64 + ne * 16 + fr];
    }
  }
  float bc[16], blast;
  lin_prep(p, l, b, g, ic, bc, blast, sGlr, sTot);
#pragma unroll
  for (int r = 0; r < 16; ++r) {
    const int t = 16 * wid + r;
    const float qv = bf2f(qraw[r]);
    const float kv = bf2f(kraw[r]);
    const float ep = __expf(bc[r]), em = __expf(-bc[r]);
    sQp[t * LSTR + lane] = f2bf(qv * ep);
    sQm[t * LSTR + lane] = f2bf(qv * em);
    sKp[t * LSTR + lane] = f2bf(kv * ep);
    sKm[t * LSTR + lane] = f2bf(kv * em);
  }
  {
    const int sr = tid >> 3, sc8 = (tid & 7) * 8;
#pragma unroll
    for (int i = 0; i < 2; ++i) {
      *(u32x4*)(sV + (sr + 32 * i) * LSTR + sc8) = vreg[i];
      *(u32x4*)(sS + (sr + 32 * i) * LSTR + sc8) = sreg[i];
    }
  }
  __syncthreads();
  bf16x8 qpf[2], qmf[2];
#pragma unroll
  for (int ks = 0; ks < 2; ++ks) {
    qpf[ks] = *(const bf16x8*)(sQp + (wid * 16 + fr) * LSTR + ks * 32 + fq * 8);
    qmf[ks] = *(const bf16x8*)(sQm + (wid * 16 + fr) * LSTR + ks * 32 + fq * 8);
  }
  float P[4][4];
#pragma unroll
  for (int ms = 0; ms < 4; ++ms) {
    f32x4 lo = (f32x4){0.f, 0.f, 0.f, 0.f}, up = (f32x4){0.f, 0.f, 0.f, 0.f};
#pragma unroll
    for (int ks = 0; ks < 2; ++ks) {
      const bf16x8 kmf = *(const bf16x8*)(sKm + (ms * 16 + fr) * LSTR + ks * 32 + fq * 8);
      const bf16x8 kpf = *(const bf16x8*)(sKp + (ms * 16 + fr) * LSTR + ks * 32 + fq * 8);
      lo = mfma16(kmf, qpf[ks], lo);
      up = mfma16(kpf, qmf[ks], up);
    }
#pragma unroll
    for (int j = 0; j < 4; ++j) {
      const int s = ms * 16 + fq * 4 + j, t = wid * 16 + fr;
      P[ms][j] = (t >= s) ? lo[j] : up[j];
    }
  }
  f32x4 o[4];
#pragma unroll
  for (int ne = 0; ne < 4; ++ne) o[ne] = (f32x4){0.f, 0.f, 0.f, 0.f};
#pragma unroll
  for (int u = 0; u < 2; ++u) {
    U4B8 pa;
    pa.u.x = pack2(P[2 * u][0], P[2 * u][1]);
    pa.u.y = pack2(P[2 * u][2], P[2 * u][3]);
    pa.u.z = pack2(P[2 * u + 1][0], P[2 * u + 1][1]);
    pa.u.w = pack2(P[2 * u + 1][2], P[2 * u + 1][3]);
#pragma unroll
    for (int ne = 0; ne < 4; ++ne) {
      U2x2B8 vf;
      vf.u[0] = *(const u32x2*)(sV + (ne * 16 + fr) * LSTR + u * 32 + fq * 4);
      vf.u[1] = *(const u32x2*)(sV + (ne * 16 + fr) * LSTR + u * 32 + 16 + fq * 4);
      o[ne] = mfma16(pa.v, vf.v, o[ne]);
    }
  }
#pragma unroll
  for (int ks = 0; ks < 2; ++ks)
#pragma unroll
    for (int ne = 0; ne < 4; ++ne) {
      const bf16x8 sf = *(const bf16x8*)(sS + (ne * 16 + fr) * LSTR + ks * 32 + fq * 8);
      o[ne] = mfma16(qpf[ks], sf, o[ne]);
    }
  const bool isret = (g < 6);
  const int mixcol = isret ? g * 64 : 768 + (g - 6) * 64;
#pragma unroll
  for (int j = 0; j < 4; ++j) {
    float s1 = (o[0][j] + o[1][j]) + (o[2][j] + o[3][j]);
#pragma unroll
    for (int of = 8; of > 0; of >>= 1) s1 += __shfl_xor(s1, of);
    const float mu = isret ? s1 * (1.f / 64.f) : 0.f;
    float s2 = 0.f;
#pragma unroll
    for (int ne = 0; ne < 4; ++ne) { const float dv = o[ne][j] - mu; s2 += dv * dv; }
#pragma unroll
    for (int of = 8; of > 0; of >>= 1) s2 += __shfl_xor(s2, of);
    const float rs = rsqrtf(s2 * (1.f / 64.f) + EPSF);
    const size_t tok = T0 + wid * 16 + fq * 4 + j;
#pragma unroll
    for (int ne = 0; ne < 4; ++ne) {
      const int e = ne * 16 + fr;
      const float gate = bf2f(graw[j][ne]);
      p.hn[tok * DM + mixcol + e] = f2bf((o[ne][j] - mu) * rs * gamv[ne] * gate);
    }
  }
}

__device__ __forceinline__ void run_phase(KParams& p, int ph, int l, unsigned char* lds, int nb, int bid) {
  const float* modl = p.mod + (size_t)l * 4 * 6144;
  switch (ph) {
    case 0:
      {
        const int CT = 16 * 60 + 16 * 16 + 16 * 88 + 44 * 16;
        const int nmod = nb > 192 ? 192 : 0;
        const int partA = nmod ? 5 * (nb - nmod) : 0;
        if (nmod == 0 || bid < nmod) mod_phase(p, lds, nb, bid);
        else convert_weights_phase(p, 0, lds, nb - nmod, bid - nmod, 0, partA < CT ? partA : CT);
        if (partA < CT) convert_weights_phase(p, 0, lds, nb, bid, partA, CT);
      }
      break;
    case 1:
      rowpass_phase(p.x, nullptr, nullptr, nullptr, nullptr, p.pre_mix_g, p.mod + 1024, p.mod, p.hn, nb, bid);
      break;
    case 2:
      proj_phase(p, l, lds, nb, bid);
      break;
    case 3:
      for (int it = bid; it < 2560; it += nb) lin_kv_item(p, l, it / 640, (it / 64) % 10, it & 63, lds);
      break;
    case 4:
      lin_scan_phase(p, nb, bid);
      break;
    case 5:
      for (int it = bid; it < 1536 + 2560; it += nb) {
        if (it < 1536) {
          sb_item(p, (it % 24) / 6, it % 6, 63 - it / 24, lds);
        } else {
          const int i2 = it - 1536;
          lin_out_item(p, l, i2 / 640, (i2 / 64) % 10, i2 & 63, lds);
        }
      }
      break;
    case 6:
      gemm_y_phase(p, p.hn, DM, p.wt_out, lds, nb, bid);
      break;
    case 7:
      rowpass_phase(l == 0 ? p.x : p.out, p.y, modl + 2048, p.post_mix_g + (size_t)l * DM, p.out, p.pre_ffn_g + (size_t)l * DM,
                    modl + 4096, modl + 3072, p.hn, nb, bid);
      break;
    case 8:
      up_phase(p, l, lds, nb, bid);
      break;
    case 9:
      gemm_y_phase(p, p.hbuf, DFF, p.wt_down, lds, nb, bid);
      break;
    case 10:
      if (l == 0) {
        rowpass_phase(p.out, p.y, modl + 5120, p.post_ffn_g, p.out, p.pre_mix_g + DM, p.mod + 4 * 6144 + 1024, p.mod + 4 * 6144, p.hn, nb, bid);
        convert_weights_phase(p, 1, lds, nb, bid, 0, 16 * 60 + 16 * 16 + 16 * 88 + 44 * 16);
      } else {
        rowpass_phase(p.out, p.y, modl + 5120, p.post_ffn_g + DM, p.out, nullptr, nullptr, nullptr, nullptr, nb, bid);
      }
      break;
  }
}


#define XB_TMO      128
#define XB_XCNT(j)  (256  + 64 * (j))
#define XB_XSUB(j)  (1280 + 64 * (j))
#define XB_XGEN(j)  (2304 + 64 * (j))
#define XB_TOP      3328
#define XB_TOPGEN   3392
#define XCD_BAR_WORDS 3456
#define XB_SPIN_CAP (1u << 20)
#define LAS __attribute__((address_space(3)))
__device__ __forceinline__ unsigned xb_ld(unsigned* p)              { return __hip_atomic_load(p, __ATOMIC_RELAXED, __HIP_MEMORY_SCOPE_AGENT); }
__device__ __forceinline__ unsigned xb_add(unsigned* p, unsigned v) { return __hip_atomic_fetch_add(p, v, __ATOMIC_RELAXED, __HIP_MEMORY_SCOPE_AGENT); }
__device__ __forceinline__ unsigned xb_xcc_id() { return (unsigned)__builtin_amdgcn_s_getreg((3 << 11) | 20) & 0xFu; }
#define XB_SPIN(cond, bar) do { unsigned _sp = 0; while (cond) { __builtin_amdgcn_s_sleep(1); \
    if ((++_sp & 255u) == 0u) { if (xb_ld(&(bar)[XB_TMO])) break; if (_sp > XB_SPIN_CAP) { atomicAdd(&(bar)[XB_TMO], 1u); break; } } } } while (0)
struct XcdBarrier { unsigned* bar; unsigned x; volatile LAS unsigned* st; };
__device__ __forceinline__ XcdBarrier xcd_barrier_post(unsigned* bar, volatile LAS unsigned* st) {
    XcdBarrier b; b.bar = bar; b.x = xb_xcc_id(); b.st = st;
    if (threadIdx.x == 0) (void)xb_add(&bar[XB_XCNT(b.x)], 1u);
    return b;
}
__device__ __forceinline__ void xcd_barrier_complete(unsigned* bar, unsigned x, unsigned& nloc, unsigned& nx) {
    const unsigned G = gridDim.x * gridDim.y * gridDim.z;
    unsigned sum, cnt, mine, sp = 0u;
    for (;;) {
        sum = 0u; cnt = 0u; mine = 0u;
#pragma unroll
        for (unsigned j = 0; j < 16; ++j) { const unsigned c = xb_ld(&bar[XB_XCNT(j)]); sum += c; cnt += (c > 0u) ? 1u : 0u; mine = (j == x) ? c : mine; }
        if (sum == G) break;
        __builtin_amdgcn_s_sleep(1);
        if ((++sp & 255u) == 0u) { if (xb_ld(&bar[XB_TMO])) break; if (sp > XB_SPIN_CAP) { atomicAdd(&bar[XB_TMO], 1u); break; } }
    }
    nloc = mine > 0u ? mine : 1u; nx = cnt > 0u ? cnt : 1u;
}
__device__ __forceinline__ void xcd_barrier(const XcdBarrier& b) {
    asm volatile("s_waitcnt vmcnt(0)" ::: "memory");
    __syncthreads();
    if (threadIdx.x == 0) {
        unsigned* bar = b.bar;
        __builtin_amdgcn_s_waitcnt(0);
        unsigned nloc = b.st[0], nx = b.st[1];
        if (nloc == 0u) { xcd_barrier_complete(bar, b.x, nloc, nx); b.st[0] = nloc; b.st[1] = nx; }
        const unsigned old = xb_add(&bar[XB_XSUB(b.x)], 1u);
        const unsigned gen = old / nloc;
        if (old + 1u == (gen + 1u) * nloc) {
            __builtin_amdgcn_fence(__ATOMIC_RELEASE, "agent");
            asm volatile("s_waitcnt vmcnt(0)" ::: "memory");
            const unsigned og = xb_add(&bar[XB_TOP], 1u);
            const unsigned tg = og / nx;
            if (og + 1u == (tg + 1u) * nx) xb_add(&bar[XB_TOPGEN], 1u);
            else XB_SPIN(xb_ld(&bar[XB_TOPGEN]) == tg, bar);
            __builtin_amdgcn_fence(__ATOMIC_ACQUIRE, "agent");
            xb_add(&bar[XB_XGEN(b.x)], 1u);
            asm volatile("s_waitcnt vmcnt(0)" ::: "memory");
        } else {
            XB_SPIN(xb_ld(&bar[XB_XGEN(b.x)]) == gen, bar);
            __builtin_amdgcn_fence(__ATOMIC_ACQUIRE, "agent");
            asm volatile("s_waitcnt vmcnt(0)" ::: "memory");
        }
    }
    __syncthreads();
}

__global__ void __launch_bounds__(256, 2) mega_kernel(Params p) {
  __shared__ __attribute__((aligned(16))) unsigned char lds[LDS_BYTES + 16];
  cg::grid_group grid = cg::this_grid();
  const int nb = gridDim.x, bid = blockIdx.x;
  volatile LAS unsigned* st = (volatile LAS unsigned*)(lds + LDS_BYTES);
  if (threadIdx.x < 4) st[threadIdx.x] = 0u;
  __syncthreads();
  if (p.x == nullptr) grid.sync();
  XcdBarrier xb = xcd_barrier_post(p.bar, st);
  for (int step = 0; step < 20; ++step) {
    const int l = step >= 11 ? 1 : 0;
    const int ph = step < 2 ? step : (step >= 11 ? step - 9 : step);
    int nb_ = nb, bid_ = bid;
    KParams* kp = (KParams*)__builtin_amdgcn_kernarg_segment_ptr();
    asm volatile("" : "+s"(nb_), "+s"(bid_), "+s"(kp));
    run_phase(*kp, ph, l, lds, nb_, bid_);
    if (step < 19) xcd_barrier(xb);
  }
}

extern "C" void kernel_launch(void* const* d_in, const int* in_sizes, int n_in, void* d_out, int out_size, void* d_ws,
                              size_t ws_size, hipStream_t stream) {
  Params p{};
  p.x = (const float*)d_in[0];
  p.c = (const float*)d_in[1];
  p.ada_w = (const float*)d_in[2];
  p.ada_b = (const float*)d_in[3];
  p.pre_mix_g = (const float*)d_in[4];
  p.post_mix_g = (const float*)d_in[5];
  p.w_in = (const float*)d_in[6];
  p.gla_w2 = (const float*)d_in[7];
  p.gla_b = (const float*)d_in[8];
  p.ret_norm_g = (const float*)d_in[9];
  p.gla_norm_g = (const float*)d_in[10];
  p.w_out = (const float*)d_in[11];
  p.pre_ffn_g = (const float*)d_in[12];
  p.post_ffn_g = (const float*)d_in[13];
  p.w_up = (const float*)d_in[14];
  p.conv_w = (const float*)d_in[15];
  p.conv_b = (const float*)d_in[16];
  p.w_down = (const float*)d_in[17];
  p.out = (float*)d_out;
  unsigned char* ws = (unsigned char*)d_ws;
  size_t off = 0;
  p.wt_in = (bf16_t*)(ws + off); off += (size_t)IN_PAD * DM * 2;
  p.wt_out = (bf16_t*)(ws + off); off += (size_t)DM * DM * 2;
  p.wt_up = (bf16_t*)(ws + off); off += (size_t)2 * DFF * DM * 2;
  p.wt_down = (bf16_t*)(ws + off); off += (size_t)DM * DFF * 2;
  p.mod = (float*)(ws + off); off += (size_t)4 * MOD_PLANE * 4;
  p.hn = (bf16_t*)(ws + off); off += (size_t)NTOK * DM * 2;
  const size_t r1 = off;
  p.lq = (bf16_t*)(ws + off); off += (size_t)NTOK * 640 * 2;
  p.lk = (bf16_t*)(ws + off); off += (size_t)NTOK * 640 * 2;
  p.lvt = (bf16_t*)(ws + off); off += (size_t)NTOK * 640 * 2;
  p.lg = (bf16_t*)(ws + off); off += (size_t)NTOK * 640 * 2;
  p.sq = (bf16_t*)(ws + off); off += (size_t)NTOK * 384 * 2;
  p.sk = (bf16_t*)(ws + off); off += (size_t)NTOK * 384 * 2;
  p.svt = (bf16_t*)(ws + off); off += (size_t)NTOK * 384 * 2;
  p.glr = (float*)(ws + off); off += (size_t)NTOK * 16 * 4;
  p.hbuf = (bf16_t*)(ws + r1);
  const size_t r2 = off;
  p.y = (bf16_t*)(ws + r2);
  p.kvt = (float*)(ws + r2);
  p.st = (bf16_t*)(ws + r2 + (size_t)40 * 64 * 4096 * 4);
  p.bl = (float*)(ws + r2 + (size_t)40 * 64 * 4096 * 4 + (size_t)40 * 64 * 4096 * 2);
  off += (size_t)NTOK * DM * 4;
  p.bar = (unsigned*)(ws + off); off += 16384;
  if (off > ws_size) { fprintf(stderr, "workspace too small: need %zu have %zu\n", off, ws_size); return; }

  static int grid_blocks = 0;
  if (!grid_blocks) {
    int dev = 0, cus = 0, per_cu = 0;
    hipGetDevice(&dev);
    hipDeviceGetAttribute(&cus, hipDeviceAttributeMultiprocessorCount, dev);
    hipOccupancyMaxActiveBlocksPerMultiprocessor(&per_cu, mega_kernel, 256, 0);
    if (per_cu > 2) per_cu = 2;
    if (per_cu < 1) per_cu = 1;
    grid_blocks = cus * per_cu;
  }
  (void)hipMemsetAsync(p.bar, 0, 16384, stream);
  void* args[] = {&p};
  hipError_t e = hipLaunchCooperativeKernel((void*)mega_kernel, dim3(grid_blocks), dim3(256), args, 0, stream);
  if (e != hipSuccess) fprintf(stderr, "cooperative launch failed: %s (grid %d)\n", hipGetErrorString(e), grid_blocks);
}
```

```cpp
#include <hip/hip_runtime.h>
#include <hip/hip_cooperative_groups.h>
#include <cstdio>
#include <cstdint>
namespace cg = cooperative_groups;

#ifndef DUPMASK
#define DUPMASK 0
#endif
#ifndef MODE_MULTI
#define MODE_MULTI 0
#endif

typedef unsigned short bf16_t;
typedef short bf16x8 __attribute__((ext_vector_type(8)));
typedef float f32x4 __attribute__((ext_vector_type(4)));
typedef unsigned u32x4 __attribute__((ext_vector_type(4)));
typedef unsigned u32x2 __attribute__((ext_vector_type(2)));

#define NTOK 16384
#define SEQ 4096
#define DM 1024
#define IN_COLS 3728
#define IN_PAD 3840
#define DFF 2816
#define LSTR 72
#define LDS_BYTES 65536
#define EPSF 1e-6f
#define LOG2E 1.4426950408889634f
#define MOD_PLANE (2 * 4 * 6144)

struct Params {
  const float *x, *c, *ada_w, *ada_b, *pre_mix_g, *post_mix_g, *w_in, *gla_w2, *gla_b, *ret_norm_g, *gla_norm_g,
      *w_out, *pre_ffn_g, *post_ffn_g, *w_up, *conv_w, *conv_b, *w_down;
  float* out;
  bf16_t *wt_in, *wt_out, *wt_up, *wt_down;
  float* mod;
  bf16_t* hn;
  bf16_t *lq, *lk, *lvt, *lg, *sq, *sk, *svt;
  float* glr;
  bf16_t* hbuf;
  bf16_t* y;
  float* kvt;
  bf16_t* st;
  float* bl;
  unsigned* bar;
};
typedef const __attribute__((address_space(4))) Params KParams;

__constant__ float ROPE_HI[32] = {1.591549367e-01f, 1.193493679e-01f, 8.949939907e-02f, 6.711508334e-02f, 5.032921210e-02f, 3.774158657e-02f, 2.830219641e-02f, 2.122365311e-02f, 1.591549441e-02f, 1.193493698e-02f, 8.949940093e-03f, 6.711508147e-03f, 5.032921210e-03f, 3.774158424e-03f, 2.830219688e-03f, 2.122365171e-03f, 1.591549488e-03f, 1.193493721e-03f, 8.949940093e-04f, 6.711508031e-04f, 5.032921326e-04f, 3.774158540e-04f, 2.830219455e-04f, 2.122365258e-04f, 1.591549371e-04f, 1.193493736e-04f, 8.949940093e-05f, 6.711508468e-05f, 5.032921035e-05f, 3.774158540e-05f, 2.830219637e-05f, 2.122365186e-05f};
__constant__ float ROPE_LO[32] = {6.420638243e-09f, 2.294664903e-09f, 2.542919653e-09f, -3.316028840e-10f, 5.173299289e-12f, -1.848551645e-09f, -5.826552019e-10f, -3.431038786e-10f, -1.029942243e-10f, 4.320196978e-11f, 6.802745173e-11f, 1.531042237e-10f, 5.173301024e-13f, 4.797548470e-11f, -1.048316434e-10f, 1.053879969e-10f, -5.686555046e-11f, -1.896286773e-11f, 6.802744999e-12f, 2.695195456e-11f, -1.158979943e-11f, -6.843983713e-12f, 1.279990003e-11f, 1.807650600e-12f, 5.954976963e-12f, -3.351478166e-12f, 6.802745216e-13f, -1.670379113e-12f, 1.751403167e-12f, -6.843983930e-13f, -5.389994549e-13f, 9.083608431e-13f};
__constant__ float LOG_GAMMA[6] = {-3.174869716e-02f, -1.574835740e-02f, -7.843177766e-03f, -3.913899418e-03f, -1.955034910e-03f, -9.770396864e-04f};

typedef __bf16 bf16v2 __attribute__((ext_vector_type(2)));
__device__ __forceinline__ unsigned pack2(float a, float b) {
  bf16v2 v;
  v[0] = (__bf16)a;
  v[1] = (__bf16)b;
  return __builtin_bit_cast(unsigned, v);
}
__device__ __forceinline__ bf16_t f2bf(float f) { return (bf16_t)(pack2(f, 0.f) & 0xffffu); }
__device__ __forceinline__ float bf2f(bf16_t h) { return __uint_as_float(((unsigned)h) << 16); }
__device__ __forceinline__ f32x4 mfma16(bf16x8 a, bf16x8 b, f32x4 c) { return __builtin_amdgcn_mfma_f32_16x16x32_bf16(a, b, c, 0, 0, 0); }
__device__ __forceinline__ float fexp2(float x) { return __builtin_amdgcn_exp2f(x); }
__device__ __forceinline__ float flog2(float x) { return __builtin_amdgcn_logf(x); }
__device__ __forceinline__ float siluf(float x) { return x * __builtin_amdgcn_rcpf(1.f + __expf(-x)); }

__device__ __forceinline__ int OTID() { int t = __builtin_amdgcn_workitem_id_x(); asm volatile("" : "+v"(t)); return t; }
__device__ __forceinline__ int UWID(int tid) { return __builtin_amdgcn_readfirstlane(tid >> 6); }

union U4B8 { u32x4 u; bf16x8 v; };
union U2x2B8 { u32x2 u[2]; bf16x8 v; };

struct GTile { const bf16_t* A; const bf16_t* Bt; int lda, ldb, row0, rlo, rhi, col0; };
__device__ __forceinline__ void gemm_issue_tile(const GTile& g, int kt, unsigned char* buf, int wid, int lane) {
  const int lr = lane >> 3, lp = lane & 7;
#pragma unroll
  for (int i = 0; i < 4; ++i) {
    const int q = wid * 4 + i;
    const int r = q * 8 + lr;
    const int c = lp ^ ((r >> 1) & 7);
    int ra = g.row0 + r;
    ra = ra < g.rlo ? g.rlo : (ra > g.rhi ? g.rhi : ra);
    const int lo = __builtin_amdgcn_readfirstlane(q * 1024);
    __builtin_amdgcn_global_load_lds((const unsigned*)(g.A + (size_t)ra * g.lda + c * 8 + kt * 64), (unsigned*)(buf + lo), 16, 0, 0);
    __builtin_amdgcn_global_load_lds((const unsigned*)(g.Bt + (size_t)(g.col0 + r) * g.ldb + c * 8 + kt * 64), (unsigned*)(buf + 16384 + lo), 16, 0, 0);
  }
}
template <bool SWAP>
__device__ __forceinline__ void gemm_mainloop(const GTile& g, const GTile& gn, bool has_next, bool first, int K, unsigned char* base, f32x4 (&acc)[4][4]) {
  const int tid = OTID(), lane = tid & 63, wid = UWID(tid), wr = wid >> 1, wc = wid & 1, fr = lane & 15, fq = lane >> 4;
  const int lr = lane >> 3, lp = lane & 7;
  const bf16_t* ap[4];
  const bf16_t* bp[4];
  int loff[4];
#pragma unroll
  for (int i = 0; i < 4; ++i) {
    const int q = wid * 4 + i;
    const int r = q * 8 + lr;
    const int c = lp ^ ((r >> 1) & 7);
    int ra = g.row0 + r;
    ra = ra < g.rlo ? g.rlo : (ra > g.rhi ? g.rhi : ra);
    ap[i] = g.A + (size_t)ra * g.lda + c * 8;
    bp[i] = g.Bt + (size_t)(g.col0 + r) * g.ldb + c * 8;
    loff[i] = __builtin_amdgcn_readfirstlane(q * 1024);
  }
#pragma unroll
  for (int m = 0; m < 4; ++m)
#pragma unroll
    for (int n = 0; n < 4; ++n) acc[m][n] = (f32x4){0.f, 0.f, 0.f, 0.f};
  int aoff[4], boff[4];
#pragma unroll
  for (int m = 0; m < 4; ++m) { const int R = wr * 64 + m * 16 + fr; aoff[m] = R * 128; }
#pragma unroll
  for (int n = 0; n < 4; ++n) { const int R = wc * 64 + n * 16 + fr; boff[n] = 16384 + R * 128; }
  const int swz = (fr >> 1) & 7;
  const int nk = K >> 6;
#define GEMM_ISSUE(KT, BUFOFF) \
  _Pragma("unroll") for (int i = 0; i < 4; ++i) { \
    __builtin_amdgcn_global_load_lds((const unsigned*)(ap[i] + (KT) * 64), (unsigned*)(base + (BUFOFF) + loff[i]), 16, 0, 0); \
    __builtin_amdgcn_global_load_lds((const unsigned*)(bp[i] + (KT) * 64), (unsigned*)(base + (BUFOFF) + 16384 + loff[i]), 16, 0, 0); }
#define DSR(dst, addr, off) asm volatile("ds_read_b128 %0, %1 offset:%2" : "=v"(dst) : "v"(addr), "n"(off))
#define GEMM_COMPUTE(BUFOFF) \
  { bf16x8 af0[4], bf0[4], af1[4], bf1[4]; \
    DSR(af0[0], adrA0, (BUFOFF)); DSR(af0[1], adrA0, (BUFOFF) + 2048); DSR(af0[2], adrA0, (BUFOFF) + 4096); DSR(af0[3], adrA0, (BUFOFF) + 6144); \
    DSR(bf0[0], adrB0, (BUFOFF) + 16384); DSR(bf0[1], adrB0, (BUFOFF) + 18432); DSR(bf0[2], adrB0, (BUFOFF) + 20480); DSR(bf0[3], adrB0, (BUFOFF) + 22528); \
    DSR(af1[0], adrA1, (BUFOFF)); DSR(af1[1], adrA1, (BUFOFF) + 2048); DSR(af1[2], adrA1, (BUFOFF) + 4096); DSR(af1[3], adrA1, (BUFOFF) + 6144); \
    DSR(bf1[0], adrB1, (BUFOFF) + 16384); DSR(bf1[1], adrB1, (BUFOFF) + 18432); DSR(bf1[2], adrB1, (BUFOFF) + 20480); DSR(bf1[3], adrB1, (BUFOFF) + 22528); \
    asm volatile("s_waitcnt lgkmcnt(8)" : "+v"(af0[0]), "+v"(af0[1]), "+v"(af0[2]), "+v"(af0[3]), "+v"(bf0[0]), "+v"(bf0[1]), "+v"(bf0[2]), "+v"(bf0[3])); \
    __builtin_amdgcn_s_setprio(1); \
    _Pragma("unroll") for (int m = 0; m < 4; ++m) \
      _Pragma("unroll") for (int n = 0; n < 4; ++n) acc[m][n] = SWAP ? mfma16(af0[m], bf0[n], acc[m][n]) : mfma16(bf0[n], af0[m], acc[m][n]); \
    __builtin_amdgcn_sched_barrier(0); \
    asm volatile("s_waitcnt lgkmcnt(0)" : "+v"(af1[0]), "+v"(af1[1]), "+v"(af1[2]), "+v"(af1[3]), "+v"(bf1[0]), "+v"(bf1[1]), "+v"(bf1[2]), "+v"(bf1[3])); \
    __builtin_amdgcn_sched_barrier(0); \
    _Pragma("unroll") for (int m = 0; m < 4; ++m) \
      _Pragma("unroll") for (int n = 0; n < 4; ++n) acc[m][n] = SWAP ? mfma16(af1[m], bf1[n], acc[m][n]) : mfma16(bf1[n], af1[m], acc[m][n]); \
    __builtin_amdgcn_s_setprio(0); }
  const unsigned lbase = (unsigned)(size_t)base;
  const unsigned adrA0 = lbase + (wr * 64 + fr) * 128 + ((0 + fq) ^ swz) * 16, adrA1 = lbase + (wr * 64 + fr) * 128 + ((4 + fq) ^ swz) * 16;
  const unsigned adrB0 = lbase + (wc * 64 + fr) * 128 + ((0 + fq) ^ swz) * 16, adrB1 = lbase + (wc * 64 + fr) * 128 + ((4 + fq) ^ swz) * 16;
  if (first) {
    __syncthreads();
    GEMM_ISSUE(0, 0)
  }
  for (int kt = 0; kt < nk; kt += 2) {
    __syncthreads();
    GEMM_ISSUE(kt + 1, 32768)
    GEMM_COMPUTE(0)
    __syncthreads();
    if (kt + 2 < nk) { GEMM_ISSUE(kt + 2, 0) }
    else if (has_next) gemm_issue_tile(gn, 0, base, wid, lane);
    GEMM_COMPUTE(32768)
  }
}

__device__ __forceinline__ bool tile_map(int t, int MT, int NT, int& mt, int& nt) {
  const int MTm = MT & ~63;
  const int nmain = MTm * NT;
  if (t < nmain) {
    const int x = t & 7, u = t >> 3;
    const int g = u / (8 * NT), rem = u - g * (8 * NT);
    nt = rem >> 3;
    mt = ((g << 3) + (rem & 7)) * 8 + x;
  } else {
    const int r = t - nmain;
    mt = MTm + r / NT;
    nt = r % NT;
  }
  return true;
}
__device__ __forceinline__ int tile_count(int MT, int NT) { return MT * NT; }

__device__ __forceinline__ void store_rows_bf16(bf16_t* buf, int ld, int row0, int colbase, const f32x4 (&acc)[4][4], float scale, bool do_silu) {
  const int lane = OTID() & 63, wid = UWID(OTID()), wr = wid >> 1, fr = lane & 15, fq = lane >> 4;
#pragma unroll
  for (int m = 0; m < 4; ++m) {
    const int row = row0 + wr * 64 + m * 16 + fr;
#pragma unroll
    for (int n = 0; n < 4; ++n) {
      f32x4 v = acc[m][n];
      if (do_silu) { v[0] = siluf(v[0]); v[1] = siluf(v[1]); v[2] = siluf(v[2]); v[3] = siluf(v[3]); }
      u32x2 w;
      w.x = pack2(v[0] * scale, v[1] * scale);
      w.y = pack2(v[2] * scale, v[3] * scale);
      *(u32x2*)(buf + (size_t)row * ld + colbase + n * 16 + fq * 4) = w;
    }
  }
}

__device__ __forceinline__ void rotary_inplace(f32x4 (&acc)[4][4], int row0) {
  const int lane = OTID() & 63, wid = UWID(OTID()), wr = wid >> 1, fr = lane & 15, fq = lane >> 4;
#pragma unroll
  for (int m = 0; m < 4; ++m) {
    const float pos = (float)((row0 + wr * 64 + m * 16 + fr) & (SEQ - 1));
#pragma unroll
    for (int n = 0; n < 2; ++n) {
#pragma unroll
      for (int j = 0; j < 4; ++j) {
        const int i = n * 16 + fq * 4 + j;
        const float fh = ROPE_HI[i], fl = ROPE_LO[i];
        const float ph = pos * fh;
        const float pe = __builtin_fmaf(pos, fh, -ph);
        float rev = (ph - floorf(ph)) + (pe + pos * fl);
        const float sn = __builtin_amdgcn_sinf(rev), cs = __builtin_amdgcn_cosf(rev);
        const float t1 = acc[m][n][j], t2 = acc[m][n + 2][j];
        acc[m][n][j] = t1 * cs - t2 * sn;
        acc[m][n + 2][j] = t1 * sn + t2 * cs;
      }
    }
  }
}

__device__ __forceinline__ void proj_phase(KParams& p, int l, unsigned char* lds, int nb, int bid) {
  const bf16_t* Bt = p.wt_in;
  const int lane = OTID() & 63, wid = UWID(OTID()), wr = wid >> 1, wc = wid & 1, fr = lane & 15, fq = lane >> 4;
  const int NT = IN_PAD / 128;
  const int ntiles = tile_count(NTOK / 128, NT);
  for (int t = bid; t < ntiles; t += nb) {
    int mt, nt, mtn = 0, ntn = 0;
    tile_map(t, NTOK / 128, NT, mt, nt);
    const bool has_next = t + nb < ntiles;
    if (has_next) tile_map(t + nb, NTOK / 128, NT, mtn, ntn);
    const int row0 = mt * 128;
    GTile g, gn;
    g.A = p.hn; g.Bt = Bt; g.lda = DM; g.ldb = DM; g.row0 = row0; g.rlo = 0; g.rhi = NTOK - 1; g.col0 = nt * 128;
    gn = g; gn.row0 = mtn * 128; gn.col0 = ntn * 128;
    const bool vt = (nt >= 6 && nt < 9) || (nt >= 18 && nt < 21) || (nt >= 25 && nt < 27);
    f32x4 acc[4][4];
    if (vt) {
      gemm_mainloop<true>(g, gn, has_next, t == bid, DM, lds, acc);
      bf16_t* dst;
      int head, nh;
      if (nt < 9) { dst = p.lvt; head = (nt - 6) * 2 + wc; nh = 10; }
      else if (nt < 21) { dst = p.svt; head = (nt - 18) * 2 + wc; nh = 6; }
      else { dst = p.lvt; head = 6 + (nt - 25) * 2 + wc; nh = 10; }
      const int b = row0 >> 12;
#pragma unroll
      for (int m = 0; m < 4; ++m) {
        const int pos = ((row0 + wr * 64 + m * 16 + fq * 4) & (SEQ - 1));
#pragma unroll
        for (int n = 0; n < 4; ++n) {
          const int e = n * 16 + fr;
          u32x2 w;
          w.x = pack2(acc[m][n][0], acc[m][n][1]);
          w.y = pack2(acc[m][n][2], acc[m][n][3]);
          *(u32x2*)(dst + ((size_t)(b * nh + head) * 64 + e) * SEQ + pos) = w;
        }
      }
    } else {
      gemm_mainloop<false>(g, gn, has_next, t == bid, DM, lds, acc);
      if (nt < 3) { rotary_inplace(acc, row0); store_rows_bf16(p.lq, 640, row0, nt * 128 + wc * 64, acc, 0.125f, false); }
      else if (nt < 6) { rotary_inplace(acc, row0); store_rows_bf16(p.lk, 640, row0, (nt - 3) * 128 + wc * 64, acc, 1.f, false); }
      else if (nt < 12) { store_rows_bf16(p.lg, 640, row0, (nt - 9) * 128 + wc * 64, acc, 1.f, true); }
      else if (nt < 15) { store_rows_bf16(p.sq, 384, row0, (nt - 12) * 128 + wc * 64, acc, 0.125f * LOG2E, false); }
      else if (nt < 18) { store_rows_bf16(p.sk, 384, row0, (nt - 15) * 128 + wc * 64, acc, 1.f, false); }
      else if (nt < 23) { store_rows_bf16(p.lq, 640, row0, 384 + (nt - 21) * 128 + wc * 64, acc, 0.125f, false); }
      else if (nt < 25) { store_rows_bf16(p.lk, 640, row0, 384 + (nt - 23) * 128 + wc * 64, acc, 1.f, false); }
      else if (nt < 29) { store_rows_bf16(p.lg, 640, row0, 384 + (nt - 27) * 128 + wc * 64, acc, 1.f, true); }
      else {
        if (wc == 0) {
#pragma unroll
          for (int m = 0; m < 4; ++m) {
            const int row = row0 + wr * 64 + m * 16 + fr;
            *(f32x4*)(p.glr + (size_t)row * 16 + fq * 4) = acc[m][0];
          }
        }
      }
    }
  }
}

__device__ __forceinline__ void gemm_y_phase(KParams& p, const bf16_t* A, int K, const bf16_t* Bt, unsigned char* lds, int nb, int bid) {
  const int lane = OTID() & 63, wid = UWID(OTID()), wr = wid >> 1, wc = wid & 1, fr = lane & 15, fq = lane >> 4;
  const int NT = DM / 128;
  const int ntiles = tile_count(NTOK / 128, NT);
  for (int t = bid; t < ntiles; t += nb) {
    int mt, nt, mtn = 0, ntn = 0;
    tile_map(t, NTOK / 128, NT, mt, nt);
    const bool has_next = t + nb < ntiles;
    if (has_next) tile_map(t + nb, NTOK / 128, NT, mtn, ntn);
    const int row0 = mt * 128;
    GTile g, gn;
    g.A = A; g.Bt = Bt; g.lda = K; g.ldb = K; g.row0 = row0; g.rlo = 0; g.rhi = NTOK - 1; g.col0 = nt * 128;
    gn = g; gn.row0 = mtn * 128; gn.col0 = ntn * 128;
    f32x4 acc[4][4];
    gemm_mainloop<false>(g, gn, has_next, t == bid, K, lds, acc);
#pragma unroll
    for (int m = 0; m < 4; ++m) {
      const int row = row0 + wr * 64 + m * 16 + fr;
#pragma unroll
      for (int n = 0; n < 4; ++n) {
        u32x2 w;
        w.x = pack2(acc[m][n][0], acc[m][n][1]);
        w.y = pack2(acc[m][n][2], acc[m][n][3]);
        *(u32x2*)(p.y + (size_t)row * DM + nt * 128 + wc * 64 + n * 16 + fq * 4) = w;
      }
    }
  }
}

__device__ __forceinline__ void up_phase(KParams& p, int l, unsigned char* lds, int nb, int bid) {
  unsigned char* sAct = lds + 32768;
  const int lane = OTID() & 63, wid = UWID(OTID()), wr = wid >> 1, wc = wid & 1, fr = lane & 15, fq = lane >> 4;
  const int NT = DFF / 64;
  const int MT = 4 * 33;
  const int ntiles = tile_count(MT, NT);
  const float* cw = p.conv_w + (size_t)l * 3 * DFF;
  const float* cb = p.conv_b + (size_t)l * DFF;
  for (int t = bid; t < ntiles; t += nb) {
    int mt, nt, mtn = 0, ntn = 0;
    tile_map(t, MT, NT, mt, nt);
    const bool has_next = t + nb < ntiles;
    if (has_next) tile_map(t + nb, MT, NT, mtn, ntn);
    const int b = mt / 33, it = mt % 33;
    const int p0 = it * 126;
    const int row0 = b * SEQ + p0 - 2;
    GTile g, gn;
    g.A = p.hn; g.Bt = p.wt_up; g.lda = DM; g.ldb = DM; g.row0 = row0; g.rlo = b * SEQ; g.rhi = b * SEQ + SEQ - 1; g.col0 = nt * 128;
    {
      const int bn = mtn / 33, itn = mtn % 33;
      gn = g; gn.row0 = bn * SEQ + itn * 126 - 2; gn.rlo = bn * SEQ; gn.rhi = bn * SEQ + SEQ - 1; gn.col0 = ntn * 128;
    }
    f32x4 cw0[2], cw1[2], cw2[2], cbb[2];
#pragma unroll
    for (int n = 0; n < 2; ++n) {
      const int fc = nt * 64 + (wc * 8 + n * 4 + fq) * 4;
      cw0[n] = *(const f32x4*)(cw + fc); cw1[n] = *(const f32x4*)(cw + DFF + fc); cw2[n] = *(const f32x4*)(cw + 2 * DFF + fc);
      cbb[n] = *(const f32x4*)(cb + fc);
    }
    f32x4 acc[4][4];
    gemm_mainloop<false>(g, gn, has_next, t == bid, DM, lds, acc);
    asm volatile("s_waitcnt lgkmcnt(0)" ::: "memory");
    __builtin_amdgcn_s_barrier();
    asm volatile("" ::: "memory");
#pragma unroll
    for (int m = 0; m < 4; ++m)
#pragma unroll
      for (int n = 0; n < 2; ++n) {
        const int r = wr * 64 + m * 16 + fr;
        const int c16 = wc * 8 + n * 4 + fq;
        *(f32x4*)(sAct + r * 256 + ((c16 ^ (r & 15)) << 4)) = acc[m][n];
      }
    asm volatile("s_waitcnt lgkmcnt(0)" ::: "memory");
    __builtin_amdgcn_s_barrier();
    asm volatile("" ::: "memory");
#pragma unroll
    for (int n = 0; n < 2; ++n) {
      const int c16 = wc * 8 + n * 4 + fq;
      const int fc = nt * 64 + c16 * 4;
      const f32x4 w0 = cw0[n], w1 = cw1[n], w2 = cw2[n];
      const f32x4 bb = cbb[n];
#pragma unroll
      for (int m = 0; m < 4; ++m) {
        const int r = wr * 64 + m * 16 + fr;
        const int pos = p0 - 2 + r;
        if (r >= 2 && pos < SEQ) {
          const f32x4 a0 = acc[m][n];
          f32x4 a1 = *(const f32x4*)(sAct + (r - 1) * 256 + ((c16 ^ ((r - 1) & 15)) << 4));
          f32x4 a2 = *(const f32x4*)(sAct + (r - 2) * 256 + ((c16 ^ ((r - 2) & 15)) << 4));
          if (pos < 1) a1 = (f32x4){0.f, 0.f, 0.f, 0.f};
          if (pos < 2) a2 = (f32x4){0.f, 0.f, 0.f, 0.f};
          float hv[4];
#pragma unroll
          for (int j = 0; j < 4; ++j) {
            const float xv = w2[j] * a0[j] + w1[j] * a1[j] + w0[j] * a2[j] + bb[j];
            const float u = 0.7978845608028654f * (xv + 0.044715f * xv * xv * xv);
            const float gl = xv * __builtin_amdgcn_rcpf(1.f + fexp2(-2.f * LOG2E * u));
            hv[j] = gl * acc[m][n + 2][j];
          }
          u32x2 w;
          w.x = pack2(hv[0], hv[1]);
          w.y = pack2(hv[2], hv[3]);
          *(u32x2*)(p.hbuf + (size_t)(b * SEQ + pos) * DFF + fc) = w;
        }
      }
    }
  }
}

__device__ __forceinline__ float wave_sum(float v) {
#pragma unroll
  for (int o = 32; o > 0; o >>= 1) v += __shfl_xor(v, o);
  return v;
}
__device__ __forceinline__ f32x4 ld_mod4(const float* ptr) {
  return ((*(const f32x4*)ptr + *(const f32x4*)(ptr + MOD_PLANE)) + *(const f32x4*)(ptr + 2 * MOD_PLANE)) + *(const f32x4*)(ptr + 3 * MOD_PLANE);
}
__device__ __forceinline__ void rowpass_phase(const float* xsrc, const bf16_t* y, const float* gate, const float* postg, float* xdst,
                              const float* preg, const float* sc, const float* sh, bf16_t* hn, int nb, int bid) {
  const int lane = OTID() & 63, wid = UWID(OTID());
  const int rpw = (NTOK + nb * 4 - 1) / (nb * 4);
  const int rbeg = (bid * 4 + wid) * rpw;
  if (rbeg >= NTOK) return;
  const int rend = rbeg + rpw < NTOK ? rbeg + rpw : NTOK;
  const int b = rbeg >> 12;
  f32x4 vg[4], vpg[4], vpre[4], vsc[4], vsh[4];
#pragma unroll
  for (int i = 0; i < 4; ++i) {
    const int col = i * 256 + lane * 4;
    if (y) { vg[i] = ld_mod4(gate + b * 6144 + col); vpg[i] = *(const f32x4*)(postg + col); }
    if (hn) { vpre[i] = *(const f32x4*)(preg + col); vsc[i] = ld_mod4(sc + b * 6144 + col) + 1.f; vsh[i] = ld_mod4(sh + b * 6144 + col); }
  }
  for (int row0 = rbeg; row0 < rend; row0 += 2) {
    f32x4 xv[2][4];
    u32x2 yr[2][4];
#pragma unroll
    for (int rr = 0; rr < 2; ++rr) {
      const int row = row0 + rr;
      if (row < rend) {
#pragma unroll
        for (int i = 0; i < 4; ++i) xv[rr][i] = __builtin_nontemporal_load((const f32x4*)(xsrc + (size_t)row * DM + i * 256 + lane * 4));
        if (y) {
#pragma unroll
          for (int i = 0; i < 4; ++i) yr[rr][i] = __builtin_nontemporal_load((const u32x2*)(y + (size_t)row * DM + i * 256 + lane * 4));
        }
      }
    }
#pragma unroll
    for (int rr = 0; rr < 2; ++rr) {
      const int row = row0 + rr;
      if (row < rend) {
        if (y) {
          f32x4 yv[4];
          float ss = 0.f;
#pragma unroll
          for (int i = 0; i < 4; ++i) {
            yv[i][0] = __uint_as_float(yr[rr][i].x << 16);
            yv[i][1] = __uint_as_float(yr[rr][i].x & 0xffff0000u);
            yv[i][2] = __uint_as_float(yr[rr][i].y << 16);
            yv[i][3] = __uint_as_float(yr[rr][i].y & 0xffff0000u);
            ss += yv[i][0] * yv[i][0] + yv[i][1] * yv[i][1] + yv[i][2] * yv[i][2] + yv[i][3] * yv[i][3];
          }
          ss = wave_sum(ss);
          const float r = rsqrtf(ss * (1.f / DM) + EPSF);
#pragma unroll
          for (int i = 0; i < 4; ++i) {
            xv[rr][i] = xv[rr][i] + vg[i] * (yv[i] * r) * vpg[i];
            __builtin_nontemporal_store(xv[rr][i], (f32x4*)(xdst + (size_t)row * DM + i * 256 + lane * 4));
          }
        }
        if (hn) {
          float ss = 0.f;
#pragma unroll
          for (int i = 0; i < 4; ++i) ss += xv[rr][i][0] * xv[rr][i][0] + xv[rr][i][1] * xv[rr][i][1] + xv[rr][i][2] * xv[rr][i][2] + xv[rr][i][3] * xv[rr][i][3];
          ss = wave_sum(ss);
          const float r = rsqrtf(ss * (1.f / DM) + EPSF);
#pragma unroll
          for (int i = 0; i < 4; ++i) {
            f32x4 h = (xv[rr][i] * r) * vpre[i] * vsc[i] + vsh[i];
            u32x2 w;
            w.x = pack2(h[0], h[1]);
            w.y = pack2(h[2], h[3]);
            *(u32x2*)(hn + (size_t)row * DM + i * 256 + lane * 4) = w;
          }
        }
      }
    }
  }
}

struct CvtDesc { const float* src; bf16_t* dst; int N, K, k0, ndst0, nsA, nsB; };
__device__ __forceinline__ CvtDesc cvt_decode(KParams& p, int l, int it) {
  const int n_in = 16 * 60, n_out = 16 * 16, n_up = 16 * 88;
  CvtDesc d;
  int i = it;
  if (i < n_in) {
    const int kt = i % 16, ntile = i / 16, ns = ntile * 64;
    d.src = p.w_in + (size_t)l * DM * IN_COLS; d.dst = p.wt_in; d.N = IN_COLS; d.K = DM; d.k0 = kt * 64; d.ndst0 = ns;
    d.nsA = ns < IN_COLS ? ns : -1; d.nsB = ns + 32 < IN_COLS ? ns + 32 : -1;
    return d;
  }
  i -= n_in;
  if (i < n_out) {
    const int kt = i % 16, ntile = i / 16;
    d.src = p.w_out + (size_t)l * DM * DM; d.dst = p.wt_out; d.N = DM; d.K = DM; d.k0 = kt * 64; d.ndst0 = ntile * 64; d.nsA = ntile * 64; d.nsB = ntile * 64 + 32;
    return d;
  }
  i -= n_out;
  if (i < n_up) {
    const int kt = i % 16, q = i / 16;
    const int j = q >> 1, wcv = q & 1;
    d.src = p.w_up + (size_t)l * DM * 2 * DFF; d.dst = p.wt_up; d.N = 2 * DFF; d.K = DM; d.k0 = kt * 64; d.ndst0 = q * 64;
    d.nsA = j * 64 + wcv * 32; d.nsB = DFF + j * 64 + wcv * 32;
    return d;
  }
  i -= n_up;
  {
    const int kt = i % 44, ntile = i / 44;
    d.src = p.w_down + (size_t)l * DFF * DM; d.dst = p.wt_down; d.N = DM; d.K = DFF; d.k0 = kt * 64; d.ndst0 = ntile * 64; d.nsA = ntile * 64; d.nsB = ntile * 64 + 32;
    return d;
  }
}
__device__ __forceinline__ void cvt_load(const CvtDesc& d, int tid, f32x4 (&v)[4]) {
  const int c4 = (tid & 15) * 4, r = tid >> 4;
  const int ns = c4 < 32 ? d.nsA : d.nsB;
  const int sc = ns + (c4 & 31);
  const bool ok = ns >= 0 && sc < d.N;
#pragma unroll
  for (int ps = 0; ps < 4; ++ps) {
    v[ps] = (f32x4){0.f, 0.f, 0.f, 0.f};
    if (ok) v[ps] = __builtin_nontemporal_load((const f32x4*)(d.src + (size_t)(d.k0 + r + 16 * ps) * d.N + sc));
  }
}

__device__ __forceinline__ void convert_weights_phase(KParams& p, int l, unsigned char* lds, int stride, int first, int lo, int hi) {
  float* tiles = (float*)lds;
  const int total = hi;
  const int tid = OTID();
  const int nb = stride, bid = lo + first;
  if (first < 0 || bid >= total) return;
  CvtDesc cur = cvt_decode(p, l, bid);
  f32x4 v[4];
  cvt_load(cur, tid, v);
  int par = 0;
  __syncthreads();
  for (int it = bid; it < total; it += nb) {
    float* tile = tiles + par * (64 * 65);
    {
      const int c4 = (tid & 15) * 4, r = tid >> 4;
#pragma unroll
      for (int ps = 0; ps < 4; ++ps) {
        const int k = r + 16 * ps;
        tile[k * 65 + c4 + 0] = v[ps][0];
        tile[k * 65 + c4 + 1] = v[ps][1];
        tile[k * 65 + c4 + 2] = v[ps][2];
        tile[k * 65 + c4 + 3] = v[ps][3];
      }
    }
    __syncthreads();
    const CvtDesc me = cur;
    if (it + nb < total) { cur = cvt_decode(p, l, it + nb); cvt_load(cur, tid, v); }
    {
      const int n = tid >> 2, kc = (tid & 3) * 16;
      unsigned w[8];
#pragma unroll
      for (int i = 0; i < 8; ++i) w[i] = pack2(tile[(kc + 2 * i) * 65 + n], tile[(kc + 2 * i + 1) * 65 + n]);
      u32x4* dd = (u32x4*)(me.dst + (size_t)(me.ndst0 + n) * me.K + me.k0 + kc);
      dd[0] = (u32x4){w[0], w[1], w[2], w[3]};
      dd[1] = (u32x4){w[4], w[5], w[6], w[7]};
    }
    par ^= 1;
  }
  __syncthreads();
}

__device__ __forceinline__ void mod_phase(KParams& p, unsigned char* lds, int nb, int bid) {
  float* sc_ = (float*)lds;
  float* red = sc_ + 4096;
  const int tid = OTID(), lane = tid & 63, wid = UWID(tid);
  for (int it = bid; it < 192; it += nb) {
    const int l = it / 96, rem = it % 96, cc = (rem >> 2) * 256, kq = rem & 3;
    __syncthreads();
    {
      f32x4 cv[4];
#pragma unroll
      for (int j = 0; j < 4; ++j) cv[j] = *(const f32x4*)(p.c + tid * 16 + j * 4);
#pragma unroll
      for (int j = 0; j < 4; ++j) {
        f32x4 r;
        r[0] = siluf(cv[j][0]); r[1] = siluf(cv[j][1]); r[2] = siluf(cv[j][2]); r[3] = siluf(cv[j][3]);
        *(f32x4*)(sc_ + tid * 16 + j * 4) = r;
      }
    }
    __syncthreads();
    const float* w = p.ada_w + (size_t)l * DM * 6144 + cc + lane * 4;
    f32x4 a0 = (f32x4){0.f, 0.f, 0.f, 0.f}, a1 = a0, a2 = a0, a3 = a0;
    const int kb = kq * 256 + wid * 64;
#pragma unroll 32
    for (int k = kb; k < kb + 64; ++k) {
      const f32x4 wv = __builtin_nontemporal_load((const f32x4*)(w + (size_t)k * 6144));
      a0 += wv * sc_[k];
      a1 += wv * sc_[1024 + k];
      a2 += wv * sc_[2048 + k];
      a3 += wv * sc_[3072 + k];
    }
    *(f32x4*)(red + (wid * 4 + 0) * 256 + lane * 4) = a0;
    *(f32x4*)(red + (wid * 4 + 1) * 256 + lane * 4) = a1;
    *(f32x4*)(red + (wid * 4 + 2) * 256 + lane * 4) = a2;
    *(f32x4*)(red + (wid * 4 + 3) * 256 + lane * 4) = a3;
    __syncthreads();
    {
      const int b = wid;
      f32x4 sv = (*(const f32x4*)(red + (0 * 4 + b) * 256 + lane * 4) + *(const f32x4*)(red + (1 * 4 + b) * 256 + lane * 4)) +
                 (*(const f32x4*)(red + (2 * 4 + b) * 256 + lane * 4) + *(const f32x4*)(red + (3 * 4 + b) * 256 + lane * 4));
      if (kq == 0) sv += *(const f32x4*)(p.ada_b + (size_t)l * 6144 + cc + lane * 4);
      *(f32x4*)(p.mod + (size_t)kq * MOD_PLANE + (size_t)(l * 4 + b) * 6144 + cc + lane * 4) = sv;
    }
  }
}

__device__ __forceinline__ void sb_item(KParams& p, int b, int h, int qt, unsigned char* lds) {
  bf16_t* sK = (bf16_t*)lds;
  bf16_t* sV = sK + 64 * LSTR;
  volatile int* sFlag = (volatile int*)(sV + 64 * LSTR);
  const int tid = OTID(), lane = tid & 63, wid = UWID(tid), fr = lane & 15, fq = lane >> 4;
  const int sr = tid >> 3, sc8 = (tid & 7) * 8;
  const size_t tokq = (size_t)b * SEQ + qt * 64 + wid * 16 + fr;
  bf16x8 qf[2];
#pragma unroll
  for (int ks = 0; ks < 2; ++ks) qf[ks] = *(const bf16x8*)(p.sq + tokq * 384 + h * 64 + ks * 32 + fq * 8);
  f32x4 o[4];
#pragma unroll
  for (int n = 0; n < 4; ++n) o[n] = (f32x4){0.f, 0.f, 0.f, 0.f};
  float carry = 0.f;
  const int tq = qt * 64 + wid * 16 + fr;
  const bf16_t* kbase = p.sk + ((size_t)b * SEQ) * 384 + h * 64 + sc8;
  const bf16_t* vbase = p.svt + ((size_t)(b * 6 + h) * 64) * SEQ + sc8;
  u32x4 kreg[2], vreg[2];
#pragma unroll
  for (int i = 0; i < 2; ++i) {
    kreg[i] = *(const u32x4*)(kbase + (size_t)(qt * 64 + sr + 32 * i) * 384);
    vreg[i] = *(const u32x4*)(vbase + (size_t)(sr + 32 * i) * SEQ + qt * 64);
  }
  __syncthreads();
  for (int kt = qt; kt >= 0; --kt) {
#pragma unroll
    for (int i = 0; i < 2; ++i) {
      *(u32x4*)(sK + (sr + 32 * i) * LSTR + sc8) = kreg[i];
      *(u32x4*)(sV + (sr + 32 * i) * LSTR + sc8) = vreg[i];
    }
    __syncthreads();
    if (kt > 0) {
#pragma unroll
      for (int i = 0; i < 2; ++i) {
        kreg[i] = *(const u32x4*)(kbase + (size_t)((kt - 1) * 64 + sr + 32 * i) * 384);
        vreg[i] = *(const u32x4*)(vbase + (size_t)(sr + 32 * i) * SEQ + (kt - 1) * 64);
      }
    }
    f32x4 z[4];
#pragma unroll
    for (int m = 0; m < 4; ++m) {
      z[m] = (f32x4){0.f, 0.f, 0.f, 0.f};
#pragma unroll
      for (int ks = 0; ks < 2; ++ks) {
        const bf16x8 kf = *(const bf16x8*)(sK + (m * 16 + fr) * LSTR + ks * 32 + fq * 8);
        z[m] = mfma16(kf, qf[ks], z[m]);
      }
    }
    float lk[4][4], lb[4][4];
    const bool diag = (kt == qt);
#pragma unroll
    for (int m = 0; m < 4; ++m)
#pragma unroll
      for (int j = 0; j < 4; ++j) {
        const float zz = z[m][j];
        const float sp = fmaxf(zz, 0.f) + flog2(1.f + fexp2(-fabsf(zz)));
        const int s = kt * 64 + m * 16 + fq * 4 + j;
        const bool valid = (!diag) || (s < tq);
        lk[m][j] = valid ? -sp : 0.f;
        lb[m][j] = valid ? (zz - sp) : -1e30f;
      }
    float tot[4], ex[4];
#pragma unroll
    for (int m = 0; m < 4; ++m) {
      const float s4 = (lk[m][0] + lk[m][1]) + (lk[m][2] + lk[m][3]);
      const float bb = __shfl_xor(s4, 16);
      const float cc = s4 + bb;
      const float dd = __shfl_xor(cc, 32);
      tot[m] = cc + dd;
      ex[m] = ((fq & 1) ? 0.f : bb) + ((fq & 2) ? 0.f : dd);
    }
    float a[4][4];
    float base = carry;
#pragma unroll
    for (int m = 3; m >= 0; --m) {
      float run = base + ex[m];
#pragma unroll
      for (int j = 3; j >= 0; --j) {
        a[m][j] = fexp2(lb[m][j] + run);
        run += lk[m][j];
      }
      base += tot[m];
    }
    carry = base;
#pragma unroll
    for (int u = 0; u < 2; ++u) {
      U4B8 pa;
      pa.u.x = pack2(a[2 * u][0], a[2 * u][1]);
      pa.u.y = pack2(a[2 * u][2], a[2 * u][3]);
      pa.u.z = pack2(a[2 * u + 1][0], a[2 * u + 1][1]);
      pa.u.w = pack2(a[2 * u + 1][2], a[2 * u + 1][3]);
#pragma unroll
      for (int n = 0; n < 4; ++n) {
        U2x2B8 vf;
        vf.u[0] = *(const u32x2*)(sV + (n * 16 + fr) * LSTR + u * 32 + fq * 4);
        vf.u[1] = *(const u32x2*)(sV + (n * 16 + fr) * LSTR + u * 32 + 16 + fq * 4);
        o[n] = mfma16(pa.v, vf.v, o[n]);
      }
    }
    {
      const int wdone = __all(carry < -180.f) ? 1 : 0;
      if (lane == 0) sFlag[wid] = wdone;
      __syncthreads();
      if (sFlag[0] & sFlag[1] & sFlag[2] & sFlag[3]) break;
    }
  }
  bf16_t* ob = p.hn + ((size_t)b * SEQ + qt * 64 + wid * 16) * DM + 384 + h * 64;
#pragma unroll
  for (int n = 0; n < 4; ++n)
#pragma unroll
    for (int j = 0; j < 4; ++j) ob[(size_t)(fq * 4 + j) * DM + n * 16 + fr] = f2bf(o[n][j]);
}

__device__ __forceinline__ void lin_prep(KParams& p, int l, int b, int g, int ic, float (&bc)[16], float& blast, float* sGlr, float* sTot) {
  const int tid = OTID(), lane = tid & 63, wid = UWID(tid);
  if (g < 6) {
    const float lg = LOG_GAMMA[g];
#pragma unroll
    for (int r = 0; r < 16; ++r) bc[r] = (float)(16 * wid + r + 1) * lg;
    blast = 64.f * lg;
  } else {
    const size_t T0 = (size_t)b * SEQ + ic * 64;
    *(f32x4*)(sGlr + tid * 4) = *(const f32x4*)(p.glr + T0 * 16 + tid * 4);
    const int c = (g - 6) * 64 + lane;
    float w2r[16];
#pragma unroll
    for (int rr = 0; rr < 16; ++rr) w2r[rr] = p.gla_w2[((size_t)l * 16 + rr) * 256 + c];
    const float gb = p.gla_b[(size_t)l * 256 + c];
    __syncthreads();
    float run = 0.f;
#pragma unroll
    for (int r = 0; r < 16; ++r) {
      const int t = 16 * wid + r;
      float xv = gb;
#pragma unroll
      for (int rr = 0; rr < 16; ++rr) xv += sGlr[t * 16 + rr] * w2r[rr];
      const float ls = -(fmaxf(-xv, 0.f) + __logf(1.f + __expf(-fabsf(xv))));
      run += ls * (1.f / 16.f);
      bc[r] = run;
    }
    sTot[wid * 64 + lane] = run;
    __syncthreads();
    float off = 0.f, tt = 0.f;
#pragma unroll
    for (int w = 0; w < 4; ++w) {
      const float v = sTot[w * 64 + lane];
      tt += v;
      if (w < wid) off += v;
    }
#pragma unroll
    for (int r = 0; r < 16; ++r) bc[r] += off;
    blast = tt;
  }
}

__device__ __forceinline__ void lin_kv_item(KParams& p, int l, int b, int g, int ic, unsigned char* lds) {
  bf16_t* sKT = (bf16_t*)lds;
  bf16_t* sV = sKT + 64 * LSTR;
  float* sGlr = (float*)(sV + 64 * LSTR);
  float* sTot = sGlr + 1024;
  const int tid = OTID(), lane = tid & 63, wid = UWID(tid), fr = lane & 15, fq = lane >> 4;
  const int bg = b * 10 + g;
  const size_t T0 = (size_t)b * SEQ + ic * 64;
  __syncthreads();
  bf16_t kraw[16];
  u32x4 vreg[2];
  {
#pragma unroll
    for (int r = 0; r < 16; ++r) kraw[r] = p.lk[(T0 + 16 * wid + r) * 640 + g * 64 + lane];
    const int sr = tid >> 3, sc8 = (tid & 7) * 8;
#pragma unroll
    for (int i = 0; i < 2; ++i) vreg[i] = *(const u32x4*)(p.lvt + ((size_t)bg * 64 + sr + 32 * i) * SEQ + ic * 64 + sc8);
  }
  float bc[16], blast;
  lin_prep(p, l, b, g, ic, bc, blast, sGlr, sTot);
  {
    unsigned w[8];
#pragma unroll
    for (int r = 0; r < 16; r += 2) {
      const float k0 = bf2f(kraw[r]);
      const float k1 = bf2f(kraw[r + 1]);
      w[r >> 1] = pack2(k0 * __expf(blast - bc[r]), k1 * __expf(blast - bc[r + 1]));
    }
    u32x4* d = (u32x4*)(sKT + lane * LSTR + 16 * wid);
    d[0] = (u32x4){w[0], w[1], w[2], w[3]};
    d[1] = (u32x4){w[4], w[5], w[6], w[7]};
  }
  {
    const int sr = tid >> 3, sc8 = (tid & 7) * 8;
#pragma unroll
    for (int i = 0; i < 2; ++i) *(u32x4*)(sV + (sr + 32 * i) * LSTR + sc8) = vreg[i];
  }
  __syncthreads();
  float* kvo = p.kvt + ((size_t)bg * 64 + ic) * 4096;
#pragma unroll
  for (int ne = 0; ne < 4; ++ne) {
    f32x4 acc = (f32x4){0.f, 0.f, 0.f, 0.f};
#pragma unroll
    for (int ks = 0; ks < 2; ++ks) {
      const bf16x8 af = *(const bf16x8*)(sKT + (wid * 16 + fr) * LSTR + ks * 32 + fq * 8);
      const bf16x8 bf = *(const bf16x8*)(sV + (ne * 16 + fr) * LSTR + ks * 32 + fq * 8);
      acc = mfma16(af, bf, acc);
    }
    __builtin_nontemporal_store(acc, (f32x4*)(kvo + (ne * 16 + fr) * 64 + wid * 16 + fq * 4));
  }
  if (wid == 0) p.bl[((size_t)bg * 64 + ic) * 64 + lane] = blast;
}

__device__ __forceinline__ void lin_scan_phase(KParams& p, int nb, int bid) {
  const int tid = OTID();
  const int total = 40 * 4096;
  const int per = (total + nb - 1) / nb;
  const int lo = bid * per, hi = lo + per < total ? lo + per : total;
  for (int base = lo; base < hi; base += 512) {
    const int e0 = base + tid, e1 = base + 256 + tid;
    const bool a0 = e0 < hi, a1 = e1 < hi;
    const int ee0 = a0 ? e0 : lo, ee1 = a1 ? e1 : lo;
    const int bg0 = ee0 >> 12, bg1 = ee1 >> 12;
    const int i0x = ee0 & 4095, i1x = ee1 & 4095;
    const float* kv0 = p.kvt + (size_t)bg0 * 64 * 4096 + i0x;
    const float* kv1 = p.kvt + (size_t)bg1 * 64 * 4096 + i1x;
    const float* bl0 = p.bl + (size_t)bg0 * 64 * 64 + (i0x & 63);
    const float* bl1 = p.bl + (size_t)bg1 * 64 * 64 + (i1x & 63);
    bf16_t* so0 = p.st + (size_t)bg0 * 64 * 4096 + i0x;
    bf16_t* so1 = p.st + (size_t)bg1 * 64 * 4096 + i1x;
    float s0 = 0.f, s1 = 0.f;
#pragma nounroll
    for (int c0 = 0; c0 < 64; c0 += 16) {
      float kva[16], da[16], kvb[16], db[16];
#pragma unroll
      for (int i = 0; i < 16; ++i) {
        kva[i] = __builtin_nontemporal_load(kv0 + (size_t)(c0 + i) * 4096);
        da[i] = bl0[(c0 + i) * 64];
      }
      if (a1) {
#pragma unroll
        for (int i = 0; i < 16; ++i) {
          kvb[i] = __builtin_nontemporal_load(kv1 + (size_t)(c0 + i) * 4096);
          db[i] = bl1[(c0 + i) * 64];
        }
      }
      if (a0) {
#pragma unroll
        for (int i = 0; i < 16; ++i) {
          so0[(size_t)(c0 + i) * 4096] = f2bf(s0);
          s0 = __expf(da[i]) * s0 + kva[i];
        }
      }
      if (a1) {
#pragma unroll
        for (int i = 0; i < 16; ++i) {
          so1[(size_t)(c0 + i) * 4096] = f2bf(s1);
          s1 = __expf(db[i]) * s1 + kvb[i];
        }
      }
    }
  }
}

__device__ __forceinline__ void lin_out_item(KParams& p, int l, int b, int g, int ic, unsigned char* lds) {
  bf16_t* sQp = (bf16_t*)lds;
  bf16_t* sQm = sQp + 64 * LSTR;
  bf16_t* sKp = sQm + 64 * LSTR;
  bf16_t* sKm = sKp + 64 * LSTR;
  bf16_t* sV = sKm + 64 * LSTR;
  bf16_t* sS = sV + 64 * LSTR;
  float* sGlr = (float*)(sS + 64 * LSTR);
  float* sTot = sGlr + 1024;
  const int tid = OTID(), lane = tid & 63, wid = UWID(tid), fr = lane & 15, fq = lane >> 4;
  const int bg = b * 10 + g;
  const size_t T0 = (size_t)b * SEQ + ic * 64;
  __syncthreads();
  bf16_t qraw[16], kraw[16];
  u32x4 vreg[2], sreg[2];
  {
#pragma unroll
    for (int r = 0; r < 16; ++r) {
      qraw[r] = p.lq[(T0 + 16 * wid + r) * 640 + g * 64 + lane];
      kraw[r] = p.lk[(T0 + 16 * wid + r) * 640 + g * 64 + lane];
    }
    const int sr = tid >> 3, sc8 = (tid & 7) * 8;
#pragma unroll
    for (int i = 0; i < 2; ++i) {
      vreg[i] = *(const u32x4*)(p.lvt + ((size_t)bg * 64 + sr + 32 * i) * SEQ + ic * 64 + sc8);
      sreg[i] = __builtin_nontemporal_load((const u32x4*)(p.st + ((size_t)bg * 64 + ic) * 4096 + (sr + 32 * i) * 64 + sc8));
    }
  }
  bf16_t graw[4][4];
  float gamv[4];
  {
    const float* gam0 = (g < 6) ? (p.ret_norm_g + (size_t)l * 384 + g * 64) : (p.gla_norm_g + (size_t)l * 256 + (g - 6) * 64);
#pragma unroll
    for (int ne = 0; ne < 4; ++ne) {
      gamv[ne] = gam0[ne * 16 + fr];
#pragma unroll
      for (int j = 0; j < 4; ++j) graw[j][ne] = p.lg[(T0 + wid * 16 + fq * 4 + j) * 640 + g * 64 + ne * 16 + fr];
    }
  }
  float bc[16], blast;
  lin_prep(p, l, b, g, ic, bc, blast, sGlr, sTot);
#pragma unroll
  for (int r = 0; r < 16; ++r) {
    const int t = 16 * wid + r;
    const float qv = bf2f(qraw[r]);
    const float kv = bf2f(kraw[r]);
    const float ep = __expf(bc[r]), em = __expf(-bc[r]);
    sQp[t * LSTR + lane] = f2bf(qv * ep);
    sQm[t * LSTR + lane] = f2bf(qv * em);
    sKp[t * LSTR + lane] = f2bf(kv * ep);
    sKm[t * LSTR + lane] = f2bf(kv * em);
  }
  {
    const int sr = tid >> 3, sc8 = (tid & 7) * 8;
#pragma unroll
    for (int i = 0; i < 2; ++i) {
      *(u32x4*)(sV + (sr + 32 * i) * LSTR + sc8) = vreg[i];
      *(u32x4*)(sS + (sr + 32 * i) * LSTR + sc8) = sreg[i];
    }
  }
  __syncthreads();
  bf16x8 qpf[2], qmf[2];
#pragma unroll
  for (int ks = 0; ks < 2; ++ks) {
    qpf[ks] = *(const bf16x8*)(sQp + (wid * 16 + fr) * LSTR + ks * 32 + fq * 8);
    qmf[ks] = *(const bf16x8*)(sQm + (wid * 16 + fr) * LSTR + ks * 32 + fq * 8);
  }
  float P[4][4];
#pragma unroll
  for (int ms = 0; ms < 4; ++ms) {
    f32x4 lo = (f32x4){0.f, 0.f, 0.f, 0.f}, up = (f32x4){0.f, 0.f, 0.f, 0.f};
#pragma unroll
    for (int ks = 0; ks < 2; ++ks) {
      const bf16x8 kmf = *(const bf16x8*)(sKm + (ms * 16 + fr) * LSTR + ks * 32 + fq * 8);
      const bf16x8 kpf = *(const bf16x8*)(sKp + (ms * 16 + fr) * LSTR + ks * 32 + fq * 8);
      lo = mfma16(kmf, qpf[ks], lo);
      up = mfma16(kpf, qmf[ks], up);
    }
#pragma unroll
    for (int j = 0; j < 4; ++j) {
      const int s = ms * 16 + fq * 4 + j, t = wid * 16 + fr;
      P[ms][j] = (t >= s) ? lo[j] : up[j];
    }
  }
  f32x4 o[4];
#pragma unroll
  for (int ne = 0; ne < 4; ++ne) o[ne] = (f32x4){0.f, 0.f, 0.f, 0.f};
#pragma unroll
  for (int u = 0; u < 2; ++u) {
    U4B8 pa;
    pa.u.x = pack2(P[2 * u][0], P[2 * u][1]);
    pa.u.y = pack2(P[2 * u][2], P[2 * u][3]);
    pa.u.z = pack2(P[2 * u + 1][0], P[2 * u + 1][1]);
    pa.u.w = pack2(P[2 * u + 1][2], P[2 * u + 1][3]);
#pragma unroll
    for (int ne = 0; ne < 4; ++ne) {
      U2x2B8 vf;
      vf.u[0] = *(const u32x2*)(sV + (ne * 16 + fr) * LSTR + u * 32 + fq * 4);
      vf.u[1] = *(const u32x2*)(sV + (ne * 16 + fr) * LSTR + u * 32 + 16 + fq * 4);
      o[ne] = mfma16(pa.v, vf.v, o[ne]);
    }
  }
#pragma unroll
  for (int ks = 0; ks < 2; ++ks)
#pragma unroll
    for (int ne = 0; ne < 4; ++ne) {
      const bf16x8 sf = *(const bf16x8*)(sS + (ne * 16 + fr) * LSTR + ks * 32 + fq * 8);
      o[ne] = mfma16(qpf[ks], sf, o[ne]);
    }
  const bool isret = (g < 6);
  const int mixcol = isret ? g * 64 : 768 + (g - 6) * 64;
#pragma unroll
  for (int j = 0; j < 4; ++j) {
    float s1 = (o[0][j] + o[1][j]) + (o[2][j] + o[3][j]);
#pragma unroll
    for (int of = 8; of > 0; of >>= 1) s1 += __shfl_xor(s1, of);
    const float mu = isret ? s1 * (1.f / 64.f) : 0.f;
    float s2 = 0.f;
#pragma unroll
    for (int ne = 0; ne < 4; ++ne) { const float dv = o[ne][j] - mu; s2 += dv * dv; }
#pragma unroll
    for (int of = 8; of > 0; of >>= 1) s2 += __shfl_xor(s2, of);
    const float rs = rsqrtf(s2 * (1.f / 64.f) + EPSF);
    const size_t tok = T0 + wid * 16 + fq * 4 + j;
#pragma unroll
    for (int ne = 0; ne < 4; ++ne) {
      const int e = ne * 16 + fr;
      const float gate = bf2f(graw[j][ne]);
      p.hn[tok * DM + mixcol + e] = f2bf((o[ne][j] - mu) * rs * gamv[ne] * gate);
    }
  }
}

__device__ __forceinline__ void run_phase(KParams& p, int ph, int l, unsigned char* lds, int nb, int bid) {
  const float* modl = p.mod + (size_t)l * 4 * 6144;
  switch (ph) {
    case 0:
      {
        const int CT = 16 * 60 + 16 * 16 + 16 * 88 + 44 * 16;
        const int nmod = nb > 192 ? 192 : 0;
        const int partA = nmod ? 5 * (nb - nmod) : 0;
        if (nmod == 0 || bid < nmod) mod_phase(p, lds, nb, bid);
        else convert_weights_phase(p, 0, lds, nb - nmod, bid - nmod, 0, partA < CT ? partA : CT);
        if (partA < CT) convert_weights_phase(p, 0, lds, nb, bid, partA, CT);
      }
      break;
    case 1:
      rowpass_phase(p.x, nullptr, nullptr, nullptr, nullptr, p.pre_mix_g, p.mod + 1024, p.mod, p.hn, nb, bid);
      break;
    case 2:
      proj_phase(p, l, lds, nb, bid);
      break;
    case 3:
      for (int it = bid; it < 2560; it += nb) lin_kv_item(p, l, it / 640, (it / 64) % 10, it & 63, lds);
      break;
    case 4:
      lin_scan_phase(p, nb, bid);
      break;
    case 5:
      for (int it = bid; it < 1536 + 2560; it += nb) {
        if (it < 1536) {
          sb_item(p, (it % 24) / 6, it % 6, 63 - it / 24, lds);
        } else {
          const int i2 = it - 1536;
          lin_out_item(p, l, i2 / 640, (i2 / 64) % 10, i2 & 63, lds);
        }
      }
      break;
    case 6:
      gemm_y_phase(p, p.hn, DM, p.wt_out, lds, nb, bid);
      break;
    case 7:
      rowpass_phase(l == 0 ? p.x : p.out, p.y, modl + 2048, p.post_mix_g + (size_t)l * DM, p.out, p.pre_ffn_g + (size_t)l * DM,
                    modl + 4096, modl + 3072, p.hn, nb, bid);
      break;
    case 8:
      up_phase(p, l, lds, nb, bid);
      break;
    case 9:
      gemm_y_phase(p, p.hbuf, DFF, p.wt_down, lds, nb, bid);
      break;
    case 10:
      if (l == 0) {
        rowpass_phase(p.out, p.y, modl + 5120, p.post_ffn_g, p.out, p.pre_mix_g + DM, p.mod + 4 * 6144 + 1024, p.mod + 4 * 6144, p.hn, nb, bid);
        convert_weights_phase(p, 1, lds, nb, bid, 0, 16 * 60 + 16 * 16 + 16 * 88 + 44 * 16);
      } else {
        rowpass_phase(p.out, p.y, modl + 5120, p.post_ffn_g + DM, p.out, nullptr, nullptr, nullptr, nullptr, nb, bid);
      }
      break;
  }
}


#define XB_TMO      128
#define XB_XCNT(j)  (256  + 64 * (j))
#define XB_XSUB(j)  (1280 + 64 * (j))
#define XB_XGEN(j)  (2304 + 64 * (j))
#define XB_TOP      3328
#define XB_TOPGEN   3392
#define XCD_BAR_WORDS 3456
#define XB_SPIN_CAP (1u << 20)
#define LAS __attribute__((address_space(3)))
__device__ __forceinline__ unsigned xb_ld(unsigned* p)              { return __hip_atomic_load(p, __ATOMIC_RELAXED, __HIP_MEMORY_SCOPE_AGENT); }
__device__ __forceinline__ unsigned xb_add(unsigned* p, unsigned v) { return __hip_atomic_fetch_add(p, v, __ATOMIC_RELAXED, __HIP_MEMORY_SCOPE_AGENT); }
__device__ __forceinline__ unsigned xb_xcc_id() { return (unsigned)__builtin_amdgcn_s_getreg((3 << 11) | 20) & 0xFu; }
#define XB_SPIN(cond, bar) do { unsigned _sp = 0; while (cond) { \
    if ((++_sp & 255u) == 0u) { if (xb_ld(&(bar)[XB_TMO])) break; if (_sp > XB_SPIN_CAP) { atomicAdd(&(bar)[XB_TMO], 1u); break; } } } } while (0)
struct XcdBarrier { unsigned* bar; unsigned x; volatile LAS unsigned* st; };
__device__ __forceinline__ XcdBarrier xcd_barrier_post(unsigned* bar, volatile LAS unsigned* st) {
    XcdBarrier b; b.bar = bar; b.x = xb_xcc_id(); b.st = st;
    if (threadIdx.x == 0) (void)xb_add(&bar[XB_XCNT(b.x)], 1u);
    return b;
}
__device__ __forceinline__ void xcd_barrier_complete(unsigned* bar, unsigned x, unsigned& nloc, unsigned& nx) {
    const unsigned G = gridDim.x * gridDim.y * gridDim.z;
    unsigned sum, cnt, mine, sp = 0u;
    for (;;) {
        sum = 0u; cnt = 0u; mine = 0u;
#pragma unroll
        for (unsigned j = 0; j < 16; ++j) { const unsigned c = xb_ld(&bar[XB_XCNT(j)]); sum += c; cnt += (c > 0u) ? 1u : 0u; mine = (j == x) ? c : mine; }
        if (sum == G) break;
        __builtin_amdgcn_s_sleep(1);
        if ((++sp & 255u) == 0u) { if (xb_ld(&bar[XB_TMO])) break; if (sp > XB_SPIN_CAP) { atomicAdd(&bar[XB_TMO], 1u); break; } }
    }
    nloc = mine > 0u ? mine : 1u; nx = cnt > 0u ? cnt : 1u;
}
__device__ __forceinline__ void xcd_barrier(const XcdBarrier& b) {
    asm volatile("s_waitcnt vmcnt(0)" ::: "memory");
    __syncthreads();
    if (threadIdx.x == 0) {
        unsigned* bar = b.bar;
        __builtin_amdgcn_s_waitcnt(0);
        unsigned nloc = b.st[0], nx = b.st[1];
        if (nloc == 0u) { xcd_barrier_complete(bar, b.x, nloc, nx); b.st[0] = nloc; b.st[1] = nx; }
        const unsigned old = xb_add(&bar[XB_XSUB(b.x)], 1u);
        const unsigned gen = old / nloc;
        if (old + 1u == (gen + 1u) * nloc) {
            __builtin_amdgcn_fence(__ATOMIC_RELEASE, "agent");
            asm volatile("s_waitcnt vmcnt(0)" ::: "memory");
            const unsigned og = xb_add(&bar[XB_TOP], 1u);
            const unsigned tg = og / nx;
            if (og + 1u == (tg + 1u) * nx) xb_add(&bar[XB_TOPGEN], 1u);
            else XB_SPIN(xb_ld(&bar[XB_TOPGEN]) == tg, bar);
            __builtin_amdgcn_fence(__ATOMIC_ACQUIRE, "agent");
            xb_add(&bar[XB_XGEN(b.x)], 1u);
            asm volatile("s_waitcnt vmcnt(0)" ::: "memory");
        } else {
            XB_SPIN(xb_ld(&bar[XB_XGEN(b.x)]) == gen, bar);
            __builtin_amdgcn_fence(__ATOMIC_ACQUIRE, "agent");
            asm volatile("s_waitcnt vmcnt(0)" ::: "memory");
        }
    }
    __syncthreads();
}

__global__ void __launch_bounds__(256, 2) mega_kernel(Params p) {
  __shared__ __attribute__((aligned(16))) unsigned char lds[LDS_BYTES + 16];
  cg::grid_group grid = cg::this_grid();
  const int nb = gridDim.x, bid = blockIdx.x;
  volatile LAS unsigned* st = (volatile LAS unsigned*)(lds + LDS_BYTES);
  if (threadIdx.x < 4) st[threadIdx.x] = 0u;
  __syncthreads();
  if (p.x == nullptr) grid.sync();
  XcdBarrier xb = xcd_barrier_post(p.bar, st);
  for (int step = 0; step < 20; ++step) {
    const int l = step >= 11 ? 1 : 0;
    const int ph = step < 2 ? step : (step >= 11 ? step - 9 : step);
    int nb_ = nb, bid_ = bid;
    KParams* kp = (KParams*)__builtin_amdgcn_kernarg_segment_ptr();
    asm volatile("" : "+s"(nb_), "+s"(bid_), "+s"(kp));
    run_phase(*kp, ph, l, lds, nb_, bid_);
    if (step < 19) xcd_barrier(xb);
  }
}

extern "C" void kernel_launch(void* const* d_in, const int* in_sizes, int n_in, void* d_out, int out_size, void* d_ws,
                              size_t ws_size, hipStream_t stream) {
  Params p{};
  p.x = (const float*)d_in[0];
  p.c = (const float*)d_in[1];
  p.ada_w = (const float*)d_in[2];
  p.ada_b = (const float*)d_in[3];
  p.pre_mix_g = (const float*)d_in[4];
  p.post_mix_g = (const float*)d_in[5];
  p.w_in = (const float*)d_in[6];
  p.gla_w2 = (const float*)d_in[7];
  p.gla_b = (const float*)d_in[8];
  p.ret_norm_g = (const float*)d_in[9];
  p.gla_norm_g = (const float*)d_in[10];
  p.w_out = (const float*)d_in[11];
  p.pre_ffn_g = (const float*)d_in[12];
  p.post_ffn_g = (const float*)d_in[13];
  p.w_up = (const float*)d_in[14];
  p.conv_w = (const float*)d_in[15];
  p.conv_b = (const float*)d_in[16];
  p.w_down = (const float*)d_in[17];
  p.out = (float*)d_out;
  unsigned char* ws = (unsigned char*)d_ws;
  size_t off = 0;
  p.wt_in = (bf16_t*)(ws + off); off += (size_t)IN_PAD * DM * 2;
  p.wt_out = (bf16_t*)(ws + off); off += (size_t)DM * DM * 2;
  p.wt_up = (bf16_t*)(ws + off); off += (size_t)2 * DFF * DM * 2;
  p.wt_down = (bf16_t*)(ws + off); off += (size_t)DM * DFF * 2;
  p.mod = (float*)(ws + off); off += (size_t)4 * MOD_PLANE * 4;
  p.hn = (bf16_t*)(ws + off); off += (size_t)NTOK * DM * 2;
  const size_t r1 = off;
  p.lq = (bf16_t*)(ws + off); off += (size_t)NTOK * 640 * 2;
  p.lk = (bf16_t*)(ws + off); off += (size_t)NTOK * 640 * 2;
  p.lvt = (bf16_t*)(ws + off); off += (size_t)NTOK * 640 * 2;
  p.lg = (bf16_t*)(ws + off); off += (size_t)NTOK * 640 * 2;
  p.sq = (bf16_t*)(ws + off); off += (size_t)NTOK * 384 * 2;
  p.sk = (bf16_t*)(ws + off); off += (size_t)NTOK * 384 * 2;
  p.svt = (bf16_t*)(ws + off); off += (size_t)NTOK * 384 * 2;
  p.glr = (float*)(ws + off); off += (size_t)NTOK * 16 * 4;
  p.hbuf = (bf16_t*)(ws + r1);
  const size_t r2 = off;
  p.y = (bf16_t*)(ws + r2);
  p.kvt = (float*)(ws + r2);
  p.st = (bf16_t*)(ws + r2 + (size_t)40 * 64 * 4096 * 4);
  p.bl = (float*)(ws + r2 + (size_t)40 * 64 * 4096 * 4 + (size_t)40 * 64 * 4096 * 2);
  off += (size_t)NTOK * DM * 4;
  p.bar = (unsigned*)(ws + off); off += 16384;
  if (off > ws_size) { fprintf(stderr, "workspace too small: need %zu have %zu\n", off, ws_size); return; }

  static int grid_blocks = 0;
  if (!grid_blocks) {
    int dev = 0, cus = 0, per_cu = 0;
    hipGetDevice(&dev);
    hipDeviceGetAttribute(&cus, hipDeviceAttributeMultiprocessorCount, dev);
    hipOccupancyMaxActiveBlocksPerMultiprocessor(&per_cu, mega_kernel, 256, 0);
    if (per_cu > 2) per_cu = 2;
    if (per_cu < 1) per_cu = 1;
    grid_blocks = cus * per_cu;
  }
  (void)hipMemsetAsync(p.bar, 0, 16384, stream);
  void* args[] = {&p};
  hipError_t e = hipLaunchCooperativeKernel((void*)mega_kernel, dim3(grid_blocks), dim3(256), args, 0, stream);
  if (e != hipSuccess) fprintf(stderr, "cooperative launch failed: %s (grid %d)\n", hipGetErrorString(e), grid_blocks);
}
```
